# Optimizing an MI355X kernel written in HIP

```python
import jax, jax.numpy as jnp
from jax import lax
import numpy as np

D_MODEL = 1024
BATCH = 8
SEQ = 4096
DEPTH = 1

CTX_LEN = 256
GRID_W = 64
D_HGRN = 512
HGRN_HEADS = 4
HGRN_HEAD_DIM = D_HGRN // HGRN_HEADS
HGRN_CHUNK = 64
D_CONV = 512
CONV_WIDTH = 31
D_MIX = D_HGRN + D_CONV
SPLITS = [D_HGRN, 2 * D_HGRN, 3 * D_HGRN, 4 * D_HGRN, 5 * D_HGRN,
          5 * D_HGRN + D_CONV, 5 * D_HGRN + 2 * D_CONV]
D_IN = 5 * D_HGRN + 3 * D_CONV
EPS = 1e-6

kernel_name = "hymba_hgrn2_conformer_dit_block"


def rmsnorm(x, g):
    xf = x.astype(jnp.float32)
    y = xf * lax.rsqrt(jnp.mean(xf * xf, axis=-1, keepdims=True) + EPS)
    return (y * g.astype(jnp.float32)).astype(x.dtype)


def layernorm(x, g, b):
    xf = x.astype(jnp.float32)
    mu = jnp.mean(xf, axis=-1, keepdims=True)
    var = jnp.mean(jnp.square(xf - mu), axis=-1, keepdims=True)
    return ((xf - mu) * lax.rsqrt(var + EPS) * g.astype(jnp.float32) + b.astype(jnp.float32)).astype(x.dtype)


def split_heads(a):
    bsz, t, _ = a.shape
    return a.reshape(bsz, t, HGRN_HEADS, HGRN_HEAD_DIM).transpose(0, 2, 1, 3)


def merge_heads(a):
    bsz, _, t, _ = a.shape
    return a.transpose(0, 2, 1, 3).reshape(bsz, t, D_HGRN)


def forget_gate(z, lb):
    f = lb + (1.0 - lb) * jax.nn.sigmoid(z.astype(jnp.float32))
    return jnp.log(f), 1.0 - f


def hgrn2_scan(q, k, v, log_f, s0):
    bsz, h, t, dk = q.shape
    dv = v.shape[-1]
    n = t // HGRN_CHUNK

    def to_chunks(a):
        return jnp.moveaxis(a.astype(jnp.float32).reshape(bsz, h, n, HGRN_CHUNK, a.shape[-1]), 2, 0)

    pos = jnp.arange(HGRN_CHUNK)
    lower_tri = pos[:, None] >= pos[None, :]

    def step(s, inp):
        qc, kc, vc, gc = inp
        b = jnp.cumsum(gc, axis=-2)
        b_last = b[..., -1:, :]
        inter = jnp.einsum('bhtd,bhde->bhte', qc * jnp.exp(b), s)
        diff = b[..., :, None, :] - b[..., None, :, :]
        decay = jnp.where(lower_tri[:, :, None], jnp.exp(jnp.minimum(diff, 0.0)), 0.0)
        scores = jnp.einsum('bhtd,bhsd,bhtsd->bhts', qc, kc, decay)
        intra = jnp.einsum('bhts,bhse->bhte', scores, vc)
        s_new = jnp.exp(b_last[..., 0, :])[..., None] * s + jnp.einsum(
            'bhsd,bhse->bhde', kc * jnp.exp(b_last - b), vc)
        return s_new, intra + inter

    s_fin, o = lax.scan(step, s0, (to_chunks(q), to_chunks(k), to_chunks(v), to_chunks(log_f)))
    o = jnp.moveaxis(o, 0, 2).reshape(bsz, h, t, dv)
    return o, s_fin


def hgrn2_bidir(q, v, z_fwd, z_bwd, lb_fwd, lb_bwd, s0_fwd, s0_bwd):
    g_f, k_f = forget_gate(z_fwd, lb_fwd)
    g_b, k_b = forget_gate(z_bwd, lb_bwd)
    qh, vh = split_heads(q), split_heads(v)
    o_f, s_f = hgrn2_scan(qh, split_heads(k_f), vh, split_heads(g_f), s0_fwd)
    flip = lambda a: jnp.flip(a, axis=2)
    o_b, s_b = hgrn2_scan(flip(qh), flip(split_heads(k_b)), flip(vh), flip(split_heads(g_b)), s0_bwd)
    o = merge_heads(o_f + flip(o_b)).astype(q.dtype)
    return o, s_f, s_b


def head_rmsnorm(o, g):
    bsz, t, _ = o.shape
    oh = o.reshape(bsz, t, HGRN_HEADS, HGRN_HEAD_DIM)
    of = oh.astype(jnp.float32)
    of = of * lax.rsqrt(jnp.mean(of * of, axis=-1, keepdims=True) + EPS)
    return (of.reshape(bsz, t, D_HGRN) * g.astype(jnp.float32)).astype(o.dtype)


def depthwise_conv2d(x, k):
    return lax.conv_general_dilated(x, k.astype(x.dtype), window_strides=(1, 1), padding='SAME',
                                    dimension_numbers=('NHWC', 'HWIO', 'NHWC'),
                                    feature_group_count=x.shape[-1])


def conv_tail(y, conv_b_l, ln_g_l, ln_b_l):
    return jax.nn.silu(layernorm(y + conv_b_l, ln_g_l, ln_b_l))


def conformer_conv_latent(u, rows, conv_w_l, conv_b_l, ln_g_l, ln_b_l):
    bsz, t, ch = u.shape
    half = ch // 2
    grid = u.reshape(bsz, rows, GRID_W, ch)
    k_row = conv_w_l[:, :half].reshape(1, CONV_WIDTH, 1, half)
    k_col = conv_w_l[:, half:].reshape(CONV_WIDTH, 1, 1, half)
    y = jnp.concatenate([depthwise_conv2d(grid[..., :half], k_row),
                         depthwise_conv2d(grid[..., half:], k_col)], axis=-1).reshape(bsz, t, ch)
    return conv_tail(y, conv_b_l, ln_g_l, ln_b_l)


def conformer_conv_context(u, conv_w_l, conv_b_l, ln_g_l, ln_b_l):
    bsz, t, ch = u.shape
    y = depthwise_conv2d(u[:, None], conv_w_l.reshape(1, CONV_WIDTH, 1, ch)).reshape(bsz, t, ch)
    return conv_tail(y, conv_b_l, ln_g_l, ln_b_l)


def merge_branches(o_hgrn, g_a, conv_y, g_b, hgrn_norm_g_l, w_out_l):
    branch_a = head_rmsnorm(o_hgrn, hgrn_norm_g_l) * jax.nn.silu(g_a)
    branch_b = conv_y * jax.nn.silu(g_b)
    return jnp.concatenate([branch_a, branch_b], axis=-1) @ w_out_l


def setup_inputs(seed: int = 0) -> dict:
    key = jax.random.key(seed)
    ks = jax.random.split(key, 20)
    nrm = jax.random.normal
    f32 = jnp.float32
    return {
        "x": nrm(ks[0], (BATCH, SEQ, D_MODEL), f32),
        "c": nrm(ks[1], (BATCH, D_MODEL), f32),
        "ctx": nrm(ks[2], (BATCH, CTX_LEN, D_MODEL), f32),
        "c_ctx": nrm(ks[3], (D_MODEL,), f32),
        "norm_g": 1.0 + 0.02 * nrm(ks[4], (DEPTH, D_MODEL), f32),
        "w_mod": 0.5 * D_MODEL ** -0.5 * nrm(ks[5], (DEPTH, D_MODEL, 3 * D_MODEL), f32),
        "b_mod": 0.02 * nrm(ks[6], (DEPTH, 3 * D_MODEL), f32),
        "w_in": D_MODEL ** -0.5 * nrm(ks[7], (DEPTH, D_MODEL, D_IN), f32),
        "lb_logits": 0.5 * nrm(ks[8], (DEPTH + 1, 2, D_HGRN), f32),
        "hgrn_norm_g": 1.0 + 0.02 * nrm(ks[9], (DEPTH, D_HGRN), f32),
        "conv_w": CONV_WIDTH ** -0.5 * nrm(ks[10], (DEPTH, CONV_WIDTH, D_CONV), f32),
        "conv_b": 0.02 * nrm(ks[11], (DEPTH, D_CONV), f32),
        "conv_ln_g": 1.0 + 0.02 * nrm(ks[12], (DEPTH, D_CONV), f32),
        "conv_ln_b": 0.02 * nrm(ks[13], (DEPTH, D_CONV), f32),
        "w_out": D_MIX ** -0.5 * nrm(ks[14], (DEPTH, D_MIX, D_MODEL), f32),
        "final_norm_g": 1.0 + 0.02 * nrm(ks[15], (D_MODEL,), f32),
    }


def reference(x, c, ctx, c_ctx, norm_g, w_mod, b_mod, w_in, lb_logits, hgrn_norm_g,
              conv_w, conv_b, conv_ln_g, conv_ln_b, w_out, final_norm_g):
    bsz, seq_len, _ = x.shape
    rows = seq_len // GRID_W
    lower_bounds = jnp.cumsum(jax.nn.softmax(lb_logits.astype(jnp.float32), axis=0), axis=0)
    zero_state = jnp.zeros((bsz, HGRN_HEADS, HGRN_HEAD_DIM, HGRN_HEAD_DIM), jnp.float32)
    h_lat, h_ctx = x, ctx
    for l in range(DEPTH):
        mod_lat = jax.nn.silu(c) @ w_mod[l] + b_mod[l]
        mod_ctx = jax.nn.silu(c_ctx) @ w_mod[l] + b_mod[l]
        sh_l, sc_l, gt_l = jnp.split(mod_lat[:, None, :], 3, axis=-1)
        sh_c, sc_c, gt_c = jnp.split(mod_ctx, 3, axis=-1)
        a_lat = rmsnorm(h_lat, norm_g[l]) * (1.0 + sc_l) + sh_l
        a_ctx = rmsnorm(h_ctx, norm_g[l]) * (1.0 + sc_c) + sh_c
        q_l, zf_l, zb_l, v_l, ga_l, u_l, ug_l, gb_l = jnp.split(a_lat @ w_in[l], SPLITS, axis=-1)
        q_c, zf_c, zb_c, v_c, ga_c, u_c, ug_c, gb_c = jnp.split(a_ctx @ w_in[l], SPLITS, axis=-1)
        lb_f, lb_b = lower_bounds[l, 0], lower_bounds[l, 1]
        o_c, s_f, s_b = hgrn2_bidir(q_c, v_c, zf_c, zb_c, lb_f, lb_b, zero_state, zero_state)
        o_l, _, _ = hgrn2_bidir(q_l, v_l, zf_l, zb_l, lb_f, lb_b, s_f, s_b)
        y_l = conformer_conv_latent(u_l * jax.nn.sigmoid(ug_l), rows, conv_w[l], conv_b[l],
                                    conv_ln_g[l], conv_ln_b[l])
        out_lat = merge_branches(o_l, ga_l, y_l, gb_l, hgrn_norm_g[l], w_out[l])
        if l < DEPTH - 1:
            y_c = conformer_conv_context(u_c * jax.nn.sigmoid(ug_c), conv_w[l], conv_b[l],
                                         conv_ln_g[l], conv_ln_b[l])
            h_ctx = h_ctx + gt_c * merge_branches(o_c, ga_c, y_c, gb_c, hgrn_norm_g[l], w_out[l])
        h_lat = h_lat + gt_l * out_lat
    return rmsnorm(h_lat, final_norm_g)
```

```cpp
#include <hip/hip_runtime.h>
#include <hip/hip_cooperative_groups.h>
#include <cstdio>
namespace cg = cooperative_groups;

#ifndef N_LAUNCHES
#define N_LAUNCHES 1
#endif

#define LAS __attribute__((address_space(3)))
typedef unsigned short bf16_t;
typedef short bf16x8 __attribute__((ext_vector_type(8)));
typedef float f32x4 __attribute__((ext_vector_type(4)));
typedef float f32x2 __attribute__((ext_vector_type(2)));
typedef unsigned u32x4 __attribute__((ext_vector_type(4)));
typedef unsigned u32x2 __attribute__((ext_vector_type(2)));

constexpr int NTHR = 512;
constexpr int DM = 1024, NLAT = 32768, NROWS = 34816;
constexpr int NCHUNK = NROWS / 64;
constexpr float EPS = 1e-6f;
constexpr int LDS_BYTES = 131072 + 16;

constexpr size_t WS_WIN = 0;
constexpr size_t WS_WOUT = 8388608;
constexpr size_t WS_MODP = 10485760;
constexpr size_t WS_RSS = 11010048;
constexpr size_t WS_BAR = 13107200;
constexpr size_t WS_A = 13631488;
constexpr size_t SZ_S = (size_t)NROWS * 512 * 2, SZ_L = (size_t)NLAT * 512 * 2;
constexpr size_t WS_QF = WS_A + (size_t)NROWS * 1024 * 2;
constexpr size_t WS_QB = WS_QF + SZ_S;
constexpr size_t WS_KF = WS_QB + SZ_S;
constexpr size_t WS_KB = WS_KF + SZ_S;
constexpr size_t WS_V = WS_KB + SZ_S;
constexpr size_t WS_GA = WS_V + SZ_S;
constexpr size_t WS_G = WS_GA + SZ_L;
constexpr size_t WS_GB = WS_G + SZ_L;
constexpr size_t WS_RT = WS_GB + SZ_L;
constexpr size_t WS_END = WS_RT + (size_t)2 * 2 * NCHUNK * 512 * 4;

struct Params {
    const float *x, *c, *ctx, *c_ctx, *norm_g, *w_mod, *b_mod, *w_in, *lb_logits, *hgrn_norm_g, *conv_w, *conv_b, *conv_ln_g, *conv_ln_b, *w_out, *final_norm_g;
    float* out; unsigned char* ws; int ph_lo, ph_hi;
};

__device__ __forceinline__ unsigned cvt_pk_bf16(float lo, float hi) { unsigned r; asm volatile("v_cvt_pk_bf16_f32 %0, %1, %2" : "=v"(r) : "v"(lo), "v"(hi)); return r; }
__device__ __forceinline__ unsigned cvt_pk_bf16_mfma(float lo, float hi) { unsigned r; asm volatile("s_nop 15\n\ts_nop 7\n\tv_cvt_pk_bf16_f32 %0, %1, %2" : "=v"(r) : "v"(lo), "v"(hi)); return r; }
__device__ __forceinline__ float bf_lo(unsigned u) { return __uint_as_float(u << 16); }
__device__ __forceinline__ float bf_hi(unsigned u) { return __uint_as_float(u & 0xffff0000u); }
__device__ __forceinline__ float sigmoidf_(float v) { return __builtin_amdgcn_rcpf(1.f + __expf(-v)); }
__device__ __forceinline__ float siluf_(float v) { return v * __builtin_amdgcn_rcpf(1.f + __expf(-v)); }


#define XB_TMO      128
#define XB_XCNT(j)  (256  + 64 * (j))
#define XB_XSUB(j)  (1280 + 64 * (j))
#define XB_XGEN(j)  (2304 + 64 * (j))
#define XB_TOP      3328
#define XB_TOPGEN   3392
#define XCD_BAR_WORDS 3456
#define XB_SPIN_CAP (1u << 18)
__device__ __forceinline__ unsigned xb_ld(unsigned* p)              { return __hip_atomic_load(p, __ATOMIC_RELAXED, __HIP_MEMORY_SCOPE_AGENT); }
__device__ __forceinline__ unsigned xb_add(unsigned* p, unsigned v) { return __hip_atomic_fetch_add(p, v, __ATOMIC_RELAXED, __HIP_MEMORY_SCOPE_AGENT); }
__device__ __forceinline__ unsigned xb_xcc_id() { return (unsigned)__builtin_amdgcn_s_getreg((3 << 11) | 20) & 0xFu; }
#define XB_SPIN(cond, bar) do { unsigned _sp = 0; while (cond) { __builtin_amdgcn_s_sleep(1); \
    if ((++_sp & 255u) == 0u) { if (xb_ld(&(bar)[XB_TMO])) break; if (_sp > XB_SPIN_CAP) { atomicAdd(&(bar)[XB_TMO], 1u); break; } } } } while (0)
struct XcdBarrier { unsigned* bar; unsigned x; volatile LAS unsigned* st; };
__device__ __forceinline__ XcdBarrier xcd_barrier_post(unsigned* bar, volatile LAS unsigned* st) {
    XcdBarrier b; b.bar = bar; b.x = xb_xcc_id(); b.st = st;
    if (threadIdx.x == 0) (void)xb_add(&bar[XB_XCNT(b.x)], 1u);
    return b;
}
__device__ __forceinline__ void xcd_barrier_complete(unsigned* bar, unsigned x, unsigned& nloc, unsigned& nx) {
    const unsigned G = gridDim.x * gridDim.y * gridDim.z;
    unsigned sum, cnt, mine, sp = 0u;
    for (;;) {
        sum = 0u; cnt = 0u; mine = 0u;
#pragma unroll
        for (unsigned j = 0; j < 16; ++j) { const unsigned c = xb_ld(&bar[XB_XCNT(j)]); sum += c; cnt += (c > 0u) ? 1u : 0u; mine = (j == x) ? c : mine; }
        if (sum == G) break;
        __builtin_amdgcn_s_sleep(1);
        if ((++sp & 255u) == 0u) { if (xb_ld(&bar[XB_TMO])) break; if (sp > XB_SPIN_CAP) { atomicAdd(&bar[XB_TMO], 1u); break; } }
    }
    nloc = mine > 0u ? mine : 1u; nx = cnt > 0u ? cnt : 1u;
}
__device__ __forceinline__ void xcd_barrier(const XcdBarrier& b) {
    asm volatile("s_waitcnt vmcnt(0)" ::: "memory");
    __syncthreads();
    if (threadIdx.x == 0) {
        unsigned* bar = b.bar;
        __builtin_amdgcn_s_waitcnt(0);
        unsigned nloc = b.st[0], nx = b.st[1];
        if (nloc == 0u) { xcd_barrier_complete(bar, b.x, nloc, nx); b.st[0] = nloc; b.st[1] = nx; }
        const unsigned old = xb_add(&bar[XB_XSUB(b.x)], 1u);
        const unsigned gen = old / nloc;
        if (old + 1u == (gen + 1u) * nloc) {
            __builtin_amdgcn_fence(__ATOMIC_RELEASE, "agent");
            asm volatile("s_waitcnt vmcnt(0)" ::: "memory");
            const unsigned og = xb_add(&bar[XB_TOP], 1u);
            const unsigned tg = og / nx;
            if (og + 1u == (tg + 1u) * nx) xb_add(&bar[XB_TOPGEN], 1u);
            else XB_SPIN(xb_ld(&bar[XB_TOPGEN]) == tg, bar);
            __builtin_amdgcn_fence(__ATOMIC_ACQUIRE, "agent");
            xb_add(&bar[XB_XGEN(b.x)], 1u);
            asm volatile("s_waitcnt vmcnt(0)" ::: "memory");
        } else {
            XB_SPIN(xb_ld(&bar[XB_XGEN(b.x)]) == gen, bar);
            __builtin_amdgcn_fence(__ATOMIC_ACQUIRE, "agent");
            asm volatile("s_waitcnt vmcnt(0)" ::: "memory");
        }
    }
    __syncthreads();
}

namespace pg8 {
constexpr int BM = 256, BK = 64, HALF = 128, HTB = HALF * BK * 2, STAGE_BYTES = 8 * HTB, NXCD = 8, WGM = 8;
__host__ __device__ __forceinline__ int lds_byte(int r, int c) { const int st = (r >> 4) * 2 + (c >> 5), rr = r & 15, cc = c & 31, ob = rr * 64 + cc * 2; return st * 1024 + (ob ^ (((ob >> 9) & 1) << 5)); }
__host__ __device__ __forceinline__ void stage_rc(int b, int& R, int& C) { const int st = b / 1024, sb = b % 1024, swz = sb ^ (((sb >> 9) & 1) << 5); R = (st >> 1) * 16 + swz / 64; C = (st & 1) * 32 + (swz % 64) / 2; }
__host__ __device__ __forceinline__ int perm32(int rho) { const int n = rho >> 4, i = rho & 15; return 8 * (i >> 2) + 4 * n + (i & 3); }
struct Unit { int pm, pn; };
struct Gemm { const bf16_t* A; const bf16_t* Bt; int M, N, K; };
struct StaticOrder {
    int nM, nN, nwg, G, c;
    __device__ void init(int M, int N, int G_, int c_) { nM = M / BM; nN = N / BM; nwg = nM * nN; G = G_; c = c_; }
    __device__ bool map(int L, Unit& u) const {
        int wgid = L; { const int q = nwg / NXCD, r = nwg % NXCD, xcd = wgid % NXCD, off = wgid / NXCD; wgid = (xcd < r ? xcd * (q + 1) : r * (q + 1) + (xcd - r) * q) + off; }
        const int nig = WGM * nN, gid = wgid / nig, fm = gid * WGM, gsz = (nM - fm) < WGM ? (nM - fm) : WGM;
        u.pm = fm + ((wgid % nig) % gsz); u.pn = (wgid % nig) / gsz; return true;
    }
    __device__ bool next(int i, Unit& u) const { const long L = (long)i * G + c; if (L >= nwg) return false; return map((int)L, u); }
};
struct InOrder : StaticOrder {
    __device__ bool next(int i, Unit& u) const {
        const long L = (long)i * G + c;
        if (L < nwg) return map((int)L, u);
        const int k = (int)(L - nwg); if (k >= 64) return false;
        u.pm = 128 + (k >> 3); u.pn = k & 7; return true;
    }
};

template <class Epi, class Sched>
__device__ __forceinline__ void gemm_phase(LAS unsigned char* lds, const Gemm g, const Sched& S, const Epi& E) {
    const int tid = threadIdx.x, wid = __builtin_amdgcn_readfirstlane(tid >> 6), lane = tid & 63, wr = wid >> 2, wc = wid & 3, fr = lane & 15, fq = lane >> 4;
    const int K = g.K, nt = K / BK;
    unsigned voffA[2], voffB[2];
#pragma unroll
    for (int i = 0; i < 2; ++i) { int R, C; stage_rc(tid * 16 + i * 8192, R, C); const int Rb = Epi::PERM ? ((R & ~31) + perm32(R & 31)) : R;
        voffA[i] = (unsigned)(R * K + C) * 2u; voffB[i] = (unsigned)(Rb * K + C) * 2u; }
    const size_t kstep = (size_t)(BK * 2);
    const size_t hstep = (size_t)HALF * K * 2;
    const size_t tstep = 2 * hstep;
    const unsigned ldsw = (unsigned)wid * 1024u;
    const int aoff = lds_byte(wr * 64 + fr, fq * 8), boff = lds_byte(wc * 32 + fr, fq * 8);
#define PG8_SA(b, h) (((b) * 2 + (h)) * HTB)
#define PG8_SB(b, h) ((4 + (b) * 2 + (h)) * HTB)
#define PG8_STAGE(bufoff, gbase, voff) do { _Pragma("unroll") for (int _i = 0; _i < 2; ++_i) \
        __builtin_amdgcn_global_load_lds((const unsigned*)((const char*)(gbase) + (voff)[_i]), (LAS unsigned*)(lds + (bufoff) + ldsw + _i * 8192), 16, 0, 0); } while (0)
#define PG8_LDA(dst, b, h) do { _Pragma("unroll") for (int m = 0; m < 4; ++m) _Pragma("unroll") for (int k = 0; k < 2; ++k) dst[m][k] = *(const LAS bf16x8*)(lds + PG8_SA(b, h) + aoff + m * 2048 + k * 1024); } while (0)
#define PG8_LDB(dst, b, h) do { _Pragma("unroll") for (int n = 0; n < 2; ++n) _Pragma("unroll") for (int k = 0; k < 2; ++k) dst[n][k] = *(const LAS bf16x8*)(lds + PG8_SB(b, h) + boff + n * 2048 + k * 1024); } while (0)
#define PG8_MMA(ai, bj, At, Bt) do { __builtin_amdgcn_s_setprio(1); _Pragma("unroll") for (int m = 0; m < 4; ++m) _Pragma("unroll") for (int n = 0; n < 2; ++n) _Pragma("unroll") for (int k = 0; k < 2; ++k) \
        acc[ai][bj][m][n] = __builtin_amdgcn_mfma_f32_16x16x32_bf16(Bt[n][k], At[m][k], acc[ai][bj][m][n], 0, 0, 0); __builtin_amdgcn_s_setprio(0); } while (0)
#define PG8_WAIT_V(n) asm volatile("s_waitcnt vmcnt(" #n ")" ::: "memory")
#define PG8_WAIT_L(n) asm volatile("s_waitcnt lgkmcnt(" #n ")" ::: "memory")
#define PG8_BAR __builtin_amdgcn_s_barrier()
#define PG8_SCHED __builtin_amdgcn_sched_barrier(0)
    Unit cur, nxt; int ui = 0;
    if (!S.next(0, cur)) return;
    f32x4 acc[2][2][4][2];
#pragma unroll
    for (int a = 0; a < 2; ++a)
#pragma unroll
        for (int b = 0; b < 2; ++b)
#pragma unroll
            for (int m = 0; m < 4; ++m)
#pragma unroll
                for (int n = 0; n < 2; ++n) acc[a][b][m][n] = (f32x4){0.f, 0.f, 0.f, 0.f};
    bf16x8 At[4][2], B0[2][2], B1[2][2];
    const char* cA = (const char*)g.A + (size_t)cur.pm * tstep; const char* cB = (const char*)g.Bt + (size_t)cur.pn * tstep;
    PG8_STAGE(PG8_SB(0, 0), cB, voffB); PG8_STAGE(PG8_SA(0, 0), cA, voffA); PG8_STAGE(PG8_SB(0, 1), cB + hstep, voffB); PG8_STAGE(PG8_SA(0, 1), cA + hstep, voffA);
    if (wr == 1) PG8_BAR;
    PG8_WAIT_V(4); PG8_BAR;
    PG8_STAGE(PG8_SB(1, 0), cB + kstep, voffB); PG8_STAGE(PG8_SA(1, 0), cA + kstep, voffA); PG8_STAGE(PG8_SB(1, 1), cB + hstep + kstep, voffB);
    PG8_WAIT_V(6); PG8_BAR;
    for (;;) {
        const bool has_next = S.next(ui + 1, nxt);
        const char* nA = has_next ? (const char*)g.A + (size_t)nxt.pm * tstep : cA; const char* nB = has_next ? (const char*)g.Bt + (size_t)nxt.pn * tstep : cB;
        for (int t = 0; t < nt; t += 2) {
            const bool last = (t == nt - 2);
            const char* a1 = cA + (size_t)(t + 1) * kstep;
            const char* a2 = last ? nA : cA + (size_t)(t + 2) * kstep; const char* b2 = last ? nB : cB + (size_t)(t + 2) * kstep;
            const char* a3 = a2 + kstep; const char* b3 = b2 + kstep;
            PG8_LDB(B0, 0, 0); PG8_SCHED; PG8_LDA(At, 0, 0); PG8_STAGE(PG8_SA(1, 1), a1 + hstep, voffA);
            PG8_WAIT_L(8); PG8_BAR; PG8_WAIT_L(0); PG8_MMA(0, 0, At, B0); PG8_BAR; PG8_SCHED;
            PG8_LDB(B1, 0, 1); PG8_STAGE(PG8_SB(0, 0), b2, voffB);
            PG8_BAR; PG8_WAIT_L(0); PG8_MMA(0, 1, At, B1); PG8_BAR;
            PG8_LDA(At, 0, 1); PG8_STAGE(PG8_SA(0, 0), a2, voffA);
            PG8_BAR; PG8_WAIT_L(0); PG8_MMA(1, 0, At, B0); PG8_BAR; PG8_SCHED;
            PG8_STAGE(PG8_SB(0, 1), b2 + hstep, voffB);
            PG8_WAIT_V(6); PG8_BAR; PG8_MMA(1, 1, At, B1); PG8_BAR;
            PG8_LDB(B0, 1, 0); PG8_SCHED; PG8_LDA(At, 1, 0); PG8_STAGE(PG8_SA(0, 1), a2 + hstep, voffA);
            PG8_WAIT_L(8); PG8_BAR; PG8_WAIT_L(0); PG8_MMA(0, 0, At, B0); PG8_BAR; PG8_SCHED;
            PG8_LDB(B1, 1, 1); PG8_STAGE(PG8_SB(1, 0), b3, voffB);
            PG8_BAR; PG8_WAIT_L(0); PG8_MMA(0, 1, At, B1); PG8_BAR;
            PG8_LDA(At, 1, 1); PG8_STAGE(PG8_SA(1, 0), a3, voffA);
            PG8_BAR; PG8_WAIT_L(0); PG8_MMA(1, 0, At, B0); PG8_BAR; PG8_SCHED;
            PG8_STAGE(PG8_SB(1, 1), b3 + hstep, voffB);
            PG8_WAIT_V(6); PG8_BAR; PG8_MMA(1, 1, At, B1); PG8_BAR;
        }
        E(acc, cur, wr, wc, fr, fq);
        if (!has_next) break;
#pragma unroll
        for (int a = 0; a < 2; ++a)
#pragma unroll
            for (int b = 0; b < 2; ++b)
#pragma unroll
                for (int m = 0; m < 4; ++m)
#pragma unroll
                    for (int n = 0; n < 2; ++n) acc[a][b][m][n] = (f32x4){0.f, 0.f, 0.f, 0.f};
        cur = nxt; cA = nA; cB = nB; ++ui;
    }
    PG8_WAIT_V(0);
    if (wr == 0) PG8_BAR;
    PG8_BAR;
#undef PG8_SA
#undef PG8_SB
#undef PG8_STAGE
#undef PG8_LDA
#undef PG8_LDB
#undef PG8_MMA
#undef PG8_WAIT_V
#undef PG8_WAIT_L
#undef PG8_BAR
#undef PG8_SCHED
}
}

template <int K> __device__ __forceinline__ float dpp_shr(float x) { return __int_as_float(__builtin_amdgcn_update_dpp(0, __float_as_int(x), 0x110 + K, 0xf, 0xf, true)); }
__device__ __forceinline__ float scan16(float x) { x += dpp_shr<1>(x); x += dpp_shr<2>(x); x += dpp_shr<4>(x); x += dpp_shr<8>(x); return x; }
__device__ __forceinline__ float clamp80(float x) { return fminf(fmaxf(x, -80.f), 80.f); }
struct EpiIn {
    static constexpr bool PERM = true;
    unsigned char* ws; const float* lb_logits;
    __device__ __forceinline__ void operator()(const f32x4 (&acc)[2][2][4][2], const pg8::Unit& u, int wr, int wc, int fr, int fq) const {
        asm volatile("s_nop 15\n\ts_nop 15\n\ts_nop 15\n\ts_nop 15" ::: "memory");
        const int row0 = u.pm * 256 + wr * 64 + fr, pn = u.pn;
        if (pn < 8) {
            bf16_t* QF = (bf16_t*)(ws + WS_QF); bf16_t* QB = (bf16_t*)(ws + WS_QB); bf16_t* KF = (bf16_t*)(ws + WS_KF); bf16_t* KB = (bf16_t*)(ws + WS_KB); bf16_t* V = (bf16_t*)(ws + WS_V);
            float* RT = (float*)(ws + WS_RT);
            const int ch0 = 64 * pn + 16 * wc + 4 * fq;
            float lbF[4], lbB[4];
#pragma unroll
            for (int j = 0; j < 4; ++j) { lbF[j] = 1.f / (1.f + __expf(lb_logits[1024 + ch0 + j] - lb_logits[ch0 + j])); lbB[j] = 1.f / (1.f + __expf(lb_logits[1536 + ch0 + j] - lb_logits[512 + ch0 + j])); }
#pragma unroll
            for (int ai = 0; ai < 2; ++ai) {
                const int rowc = u.pm * 256 + 128 * ai + 64 * wr;
                const int cid = rowc >> 6;
                unsigned oQF[4][2], oQB[4][2], oKF[4][2], oKB[4][2]; f32x4 rtv[4];
#pragma unroll
                for (int jp = 0; jp < 2; ++jp) {
                    float vQF[4][2], vQB[4][2], vKF[4][2], vKB[4][2];
#pragma unroll
                    for (int jj = 0; jj < 2; ++jj) {
                        const int j = 2 * jp + jj;
                        float lfF[4], kkF[4], lfB[4], kkB[4], pF[4], pB[4], tF[4], tB[4];
#pragma unroll
                        for (int m = 0; m < 4; ++m) {
                            { const float z = acc[ai][0][m][1][j]; const float e = __expf(fminf(-z, 30.f)); const float s = __builtin_amdgcn_rcpf(1.f + e); lfF[m] = __logf(lbF[j] + (1.f - lbF[j]) * s); kkF[m] = (1.f - lbF[j]) * e * s; }
                            { const float z = acc[ai][1][m][0][j]; const float e = __expf(fminf(-z, 30.f)); const float s = __builtin_amdgcn_rcpf(1.f + e); lfB[m] = __logf(lbB[j] + (1.f - lbB[j]) * s); kkB[m] = (1.f - lbB[j]) * e * s; }
                            pF[m] = scan16(lfF[m]); pB[m] = scan16(lfB[m]);
                            tF[m] = __shfl(pF[m], 15, 16); tB[m] = __shfl(pB[m], 15, 16);
                        }
                        const float rF = tF[0] + tF[1], blF = rF + tF[2] + tF[3];
                        const float rB = tB[2] + tB[3], blB = rB + tB[0] + tB[1];
                        float cF = 0.f, cB = 0.f;
#pragma unroll
                        for (int m = 0; m < 4; ++m) {
                            const float bF = pF[m] + cF; cF += tF[m];
                            const float bB = blB - (pB[m] + cB) + lfB[m]; cB += tB[m];
                            const float xF = clamp80(bF - rF), xB = clamp80(bB - rB);
                            const float q = acc[ai][0][m][0][j];
                            vQF[m][jj] = q * __expf(xF); vKF[m][jj] = kkF[m] * __expf(-xF);
                            vQB[m][jj] = q * __expf(xB); vKB[m][jj] = kkB[m] * __expf(-xB);
                        }
                        rtv[0][j] = rF; rtv[1][j] = rB; rtv[2][j] = blF - rF; rtv[3][j] = blB - rB;
                    }
#pragma unroll
                    for (int m = 0; m < 4; ++m) { oQF[m][jp] = cvt_pk_bf16(vQF[m][0], vQF[m][1]); oQB[m][jp] = cvt_pk_bf16(vQB[m][0], vQB[m][1]); oKF[m][jp] = cvt_pk_bf16(vKF[m][0], vKF[m][1]); oKB[m][jp] = cvt_pk_bf16(vKB[m][0], vKB[m][1]); }
                }
                if (fr == 0) {
#pragma unroll
                    for (int t = 0; t < 4; ++t) *(f32x4*)(RT + (size_t)t * NCHUNK * 512 + (size_t)cid * 512 + ch0) = rtv[t];
                }
#pragma unroll
                for (int mp = 0; mp < 2; ++mp) {
                    const int a = 2 * mp, bb = 2 * mp + 1, odd = fq & 1;
                    const size_t off = (size_t)(rowc + 16 * (odd ? bb : a) + fr) * 512 + (ch0 - 4 * odd);
                    const f32x4 va = acc[ai][1][a][1], vb = acc[ai][1][bb][1];
                    const unsigned oVa0 = cvt_pk_bf16(va[0], va[1]), oVa1 = cvt_pk_bf16(va[2], va[3]), oVb0 = cvt_pk_bf16(vb[0], vb[1]), oVb1 = cvt_pk_bf16(vb[2], vb[3]);
                    asm volatile("s_nop 1" ::: "memory");
#define WIDE_ST(P, x0a, x1a, x0b, x1b) do { const u32x2 s0 = __builtin_amdgcn_permlane16_swap((x0a), (x0b), false, false), s1 = __builtin_amdgcn_permlane16_swap((x1a), (x1b), false, false); \
                        *(u32x4*)((P) + off) = (u32x4){s0[0], s1[0], s0[1], s1[1]}; } while (0)
                    WIDE_ST(QF, oQF[a][0], oQF[a][1], oQF[bb][0], oQF[bb][1]); WIDE_ST(QB, oQB[a][0], oQB[a][1], oQB[bb][0], oQB[bb][1]);
                    WIDE_ST(KF, oKF[a][0], oKF[a][1], oKF[bb][0], oKF[bb][1]); WIDE_ST(KB, oKB[a][0], oKB[a][1], oKB[bb][0], oKB[bb][1]);
                    WIDE_ST(V, oVa0, oVa1, oVb0, oVb1);
#undef WIDE_ST
                }
            }
        } else if (pn >= 10 && pn <= 13) {
            bf16_t* G = (bf16_t*)(ws + WS_G);
            const int chb = 128 * (pn - 10) + 16 * wc + 4 * fq;
            const int odd = fq & 1;
#pragma unroll
            for (int ai = 0; ai < 2; ++ai)
#pragma unroll
                for (int mp = 0; mp < 2; ++mp) {
                    const size_t row = (size_t)(row0 + ai * 128 + (2 * mp + odd) * 16);
#pragma unroll
                    for (int bj = 0; bj < 2; ++bj) {
                        const f32x4 ua = acc[ai][bj][2 * mp][0], ga = acc[ai][bj][2 * mp][1], ub = acc[ai][bj][2 * mp + 1][0], gb = acc[ai][bj][2 * mp + 1][1];
                        const unsigned a0 = cvt_pk_bf16(ua[0] * sigmoidf_(ga[0]), ua[1] * sigmoidf_(ga[1])), a1 = cvt_pk_bf16(ua[2] * sigmoidf_(ga[2]), ua[3] * sigmoidf_(ga[3]));
                        const unsigned b0 = cvt_pk_bf16(ub[0] * sigmoidf_(gb[0]), ub[1] * sigmoidf_(gb[1])), b1 = cvt_pk_bf16(ub[2] * sigmoidf_(gb[2]), ub[3] * sigmoidf_(gb[3]));
                        asm volatile("s_nop 1" ::: "memory");
                        const u32x2 s0 = __builtin_amdgcn_permlane16_swap(a0, b0, false, false), s1 = __builtin_amdgcn_permlane16_swap(a1, b1, false, false);
                        *(u32x4*)(G + row * 512 + (chb - 4 * odd) + 64 * bj) = (u32x4){s0[0], s1[0], s0[1], s1[1]};
                    }
                }
        } else {
            bf16_t* D = (bf16_t*)(ws + (pn < 10 ? WS_GA : WS_GB));
            const int colb = 256 * (pn < 10 ? pn - 8 : pn - 14) + 32 * wc + 8 * fq;
#pragma unroll
            for (int ai = 0; ai < 2; ++ai)
#pragma unroll
                for (int m = 0; m < 4; ++m) {
                    const size_t row = (size_t)(row0 + ai * 128 + m * 16);
#pragma unroll
                    for (int bj = 0; bj < 2; ++bj) {
                        f32x4 v0 = acc[ai][bj][m][0], v1 = acc[ai][bj][m][1];
#pragma unroll
                        for (int j = 0; j < 4; ++j) { v0[j] = siluf_(v0[j]); v1[j] = siluf_(v1[j]); }
                        u32x4 o = {cvt_pk_bf16(v0[0], v0[1]), cvt_pk_bf16(v0[2], v0[3]), cvt_pk_bf16(v1[0], v1[1]), cvt_pk_bf16(v1[2], v1[3])};
                        *(u32x4*)(D + row * 512 + colb + 128 * bj) = o;
                    }
                }
        }
    }
};

struct EpiOut {
    static constexpr bool PERM = true;
    bf16_t* Y;
    __device__ __forceinline__ void operator()(const f32x4 (&acc)[2][2][4][2], const pg8::Unit& u, int wr, int wc, int fr, int fq) const {
        asm volatile("s_nop 15\n\ts_nop 15\n\ts_nop 15\n\ts_nop 15" ::: "memory");
        const int row0 = u.pm * 256 + wr * 64 + fr, col0 = u.pn * 256 + wc * 32 + 8 * fq;
#pragma unroll
        for (int ai = 0; ai < 2; ++ai)
#pragma unroll
            for (int m = 0; m < 4; ++m) {
                const size_t row = (size_t)(row0 + ai * 128 + m * 16);
#pragma unroll
                for (int bj = 0; bj < 2; ++bj) {
                    const f32x4 v0 = acc[ai][bj][m][0], v1 = acc[ai][bj][m][1];
                    u32x4 o = {cvt_pk_bf16(v0[0], v0[1]), cvt_pk_bf16(v0[2], v0[3]), cvt_pk_bf16(v1[0], v1[1]), cvt_pk_bf16(v1[2], v1[3])};
                    *(u32x4*)(Y + row * 1024 + col0 + 128 * bj) = o;
                }
            }
    }
};

__device__ void phase0(LAS unsigned char* lds, const Params& p, int it_lo, int it_hi) {
    const int tid = threadIdx.x;
    LAS float* fl = (LAS float*)lds;
    float* modp = (float*)(p.ws + WS_MODP);
    for (int it = it_lo + blockIdx.x; it < it_hi; it += gridDim.x) {
        if (it < 192) {
            const int cc = it % 48, kq = it / 48;
            LAS float* sil = fl; LAS float* red = fl + 2304;
            for (int i = tid; i < 2304; i += NTHR) { const int j = i >> 8, k = kq * 256 + (i & 255); const float v = (j < 8) ? p.c[j * 1024 + k] : p.c_ctx[k]; sil[i] = siluf_(v); }
            __syncthreads();
            const int n = tid & 63, ks = tid >> 6;
            const float* wp = p.w_mod + (size_t)(kq * 256 + ks * 32) * 3072 + cc * 64 + n;
            float a[9];
#pragma unroll
            for (int j = 0; j < 9; ++j) a[j] = 0.f;
#pragma unroll 8
            for (int kk = 0; kk < 32; ++kk) { const float w = wp[(size_t)kk * 3072];
#pragma unroll
                for (int j = 0; j < 9; ++j) a[j] += sil[j * 256 + ks * 32 + kk] * w; }
#pragma unroll
            for (int j = 0; j < 9; ++j) red[(ks * 9 + j) * 64 + n] = a[j];
            __syncthreads();
            for (int i = tid; i < 576; i += NTHR) { const int j = i >> 6, nn = i & 63; float s = 0.f;
#pragma unroll
                for (int k2 = 0; k2 < 8; ++k2) s += red[(k2 * 9 + j) * 64 + nn];
                modp[(kq * 9 + j) * 3072 + cc * 64 + nn] = s; }
            __syncthreads();
        } else {
            int t = it - 192; const float* W; bf16_t* WT; int N; bool isin;
            if (t < 1024) { W = p.w_in; WT = (bf16_t*)(p.ws + WS_WIN); N = 4096; isin = true; } else { t -= 1024; W = p.w_out; WT = (bf16_t*)(p.ws + WS_WOUT); N = 1024; isin = false; }
            const int kt = t & 15, nt = t >> 4;
            const int n = tid & 63, k0 = tid >> 6;
            const int ncol = nt * 64 + n; int src = ncol;
            if (isin && ncol < 2048) { const int pnn = ncol >> 8, cc = ncol & 255; const int type = ((cc >> 7) << 1) | ((cc >> 2) & 1); src = type * 512 + 64 * pnn + 16 * ((cc >> 5) & 3) + 4 * ((cc >> 3) & 3) + (cc & 3); }
            else if (isin && ncol >= 2560 && ncol < 3584) { const int mm = ncol - 2560, g = mm >> 3, i = mm & 7; src = (i < 4) ? 2560 + 4 * g + i : 3072 + 4 * g + (i - 4); }
#pragma unroll
            for (int ps = 0; ps < 8; ++ps) { const int k = ps * 8 + k0; fl[k * 65 + n] = W[(size_t)(kt * 64 + k) * N + src]; }
            __syncthreads();
            const int nn = tid >> 3, k8 = tid & 7;
            float v[8];
#pragma unroll
            for (int j = 0; j < 8; ++j) v[j] = fl[(k8 * 8 + j) * 65 + nn];
            u32x4 o = {cvt_pk_bf16(v[0], v[1]), cvt_pk_bf16(v[2], v[3]), cvt_pk_bf16(v[4], v[5]), cvt_pk_bf16(v[6], v[7])};
            *(u32x4*)(WT + (size_t)(nt * 64 + nn) * 1024 + kt * 64 + k8 * 8) = o;
            __syncthreads();
        }
    }
}

__device__ void phase1(LAS unsigned char* lds, const Params& p) {
    const int tid = threadIdx.x, w = tid >> 6, lane = tid & 63;
    LAS float* mv = (LAS float*)lds;
    const float* modp = (const float*)(p.ws + WS_MODP);
    bf16_t* A = (bf16_t*)(p.ws + WS_A);
    const int ngrp = NROWS / 8;
    const int g0 = (int)((long)blockIdx.x * ngrp / gridDim.x), g1 = (int)((long)(blockIdx.x + 1) * ngrp / gridDim.x);
    int curj = -1;
    for (int g = g0; g < g1; ++g) {
        const int row0 = g * 8; const int j = row0 < NLAT ? (row0 >> 12) : 8;
        if (j != curj) {
            __syncthreads();
            for (int i = tid; i < 1024; i += NTHR) { float sh = p.b_mod[i], sc = p.b_mod[1024 + i];
#pragma unroll
                for (int q = 0; q < 4; ++q) { sh += modp[(q * 9 + j) * 3072 + i]; sc += modp[(q * 9 + j) * 3072 + 1024 + i]; }
                mv[i] = p.norm_g[i] * (1.f + sc); mv[1024 + i] = sh; }
            __syncthreads(); curj = j;
        }
        const int row = row0 + w;
        const float* xr = row < NLAT ? p.x + (size_t)row * 1024 : p.ctx + (size_t)(row - NLAT) * 1024;
        f32x4 v[4]; float ss = 0.f;
#pragma unroll
        for (int c = 0; c < 4; ++c) { v[c] = *(const f32x4*)(xr + c * 256 + lane * 4); ss += v[c][0] * v[c][0] + v[c][1] * v[c][1] + v[c][2] * v[c][2] + v[c][3] * v[c][3]; }
#pragma unroll
        for (int m = 32; m >= 1; m >>= 1) ss += __shfl_xor(ss, m);
        const float rs = rsqrtf(ss * (1.f / 1024.f) + EPS);
#pragma unroll
        for (int c = 0; c < 4; ++c) { const int k = c * 256 + lane * 4; const f32x4 m0 = *(const LAS f32x4*)(mv + k), m1 = *(const LAS f32x4*)(mv + 1024 + k);
            const f32x4 a = v[c] * rs * m0 + m1; u32x2 o = {cvt_pk_bf16(a[0], a[1]), cvt_pk_bf16(a[2], a[3])}; *(u32x2*)(A + (size_t)row * 1024 + k) = o; }
    }
}

#define MFMA16(a, b, c) __builtin_amdgcn_mfma_f32_16x16x32_bf16((a), (b), (c), 0, 0, 0)
__device__ __forceinline__ int scan_cid(int n, int dir, int b) { return n < 4 ? 512 + b * 4 + (dir ? 3 - n : n) : b * 64 + (dir ? 67 - n : n - 4); }
#define SCAN_BAR() asm volatile("s_waitcnt lgkmcnt(0)\n\ts_barrier" ::: "memory")
#define SB_() __builtin_amdgcn_sched_barrier(0)
typedef short s16x4 __attribute__((ext_vector_type(4)));
__device__ __forceinline__ bf16x8 tr_pair(const LAS bf16_t* img, int stride, int r0a, int r0b, int c0, int ln) {
    const int q = ln >> 2, p = ln & 3;
    const s16x4 a = __builtin_amdgcn_ds_read_tr16_b64_v4i16((LAS s16x4*)(img + (r0a + q) * stride + c0 + 4 * p));
    const s16x4 b = __builtin_amdgcn_ds_read_tr16_b64_v4i16((LAS s16x4*)(img + (r0b + q) * stride + c0 + 4 * p));
    return __builtin_shufflevector(a, b, 0, 1, 2, 3, 4, 5, 6, 7);
}
__device__ void scan_phase(LAS unsigned char* lds, const Params& p) {
    const int tid = threadIdx.x, w = __builtin_amdgcn_readfirstlane(tid >> 6), lane = tid & 63, ln = lane & 15, lq = lane >> 4;
    constexpr int QST = 136, VST = 36;
    constexpr int OFF_KS = 17408, OFF_V = 34816, BUFB = 39424;
    LAS bf16_t* Sr = (LAS bf16_t*)(lds + 2 * BUFB);
    LAS float* scs = (LAS float*)(lds + 2 * BUFB + 9216);
    bf16_t* O = (bf16_t*)p.out;
    bf16_t* Odummy = (bf16_t*)(p.ws + WS_A) + (size_t)blockIdx.x * 64 * 512;
    const float* RT = (const float*)(p.ws + WS_RT);
    const int eb = w & 1, tb = w >> 1;
    for (int item = blockIdx.x; item < 256; item += gridDim.x) {
        const int seq = (item & 7) + 8 * (item >> 5), es = (item >> 3) & 3;
        const int dir = seq & 1, h = (seq >> 1) & 3, b = seq >> 3;
        const char* Qx = (const char*)((const bf16_t*)(p.ws + (dir ? WS_QB : WS_QF)) + h * 128);
        const char* Kx = (const char*)((const bf16_t*)(p.ws + (dir ? WS_KB : WS_KF)) + h * 128);
        const char* Vx = (const char*)((const bf16_t*)(p.ws + WS_V) + h * 128 + es * 32);
        const char* Rx = (const char*)(RT + (size_t)dir * NCHUNK * 512 + h * 128);
        const char* Tx = (const char*)(RT + (size_t)(2 + dir) * NCHUNK * 512 + h * 128);
        const unsigned qoff0 = (unsigned)((dir ? 63 - (tid >> 4) : (tid >> 4)) * 1024 + (tid & 15) * 16), qstep = dir ? (unsigned)-32768 : 32768u;
        const unsigned voff = (unsigned)((dir ? 63 - (tid >> 3) : (tid >> 3)) * 1024 + (tid & 7) * 8), roff = (unsigned)(tid & 127) * 4u;
        f32x4 S[2] = {(f32x4){0.f, 0.f, 0.f, 0.f}, (f32x4){0.f, 0.f, 0.f, 0.f}};
        float tailp = 0.f;
        u32x4 k4A[2], k4B[2], k4C[2], k4D[2]; u32x4 q4A[2], q4B[2], q4C[2], q4D[2]; u32x2 v4A, v4B, v4C, v4D; float rvA, tlA, rvB, tlB, rvC, tlC, rvD, tlD;
#define SCAN_LOAD(n, k4, q4, v4, rv, tl) do { const size_t cb_ = (size_t)scan_cid((n), dir, b) * 65536; const size_t rb_ = (size_t)scan_cid((n), dir, b) * 2048; SB_(); \
            _Pragma("unroll") for (int i = 0; i < 2; ++i) { k4[i] = *(const u32x4*)(Kx + cb_ + (qoff0 + (unsigned)i * qstep)); SB_(); } \
            _Pragma("unroll") for (int i = 0; i < 2; ++i) { q4[i] = *(const u32x4*)(Qx + cb_ + (qoff0 + (unsigned)i * qstep)); SB_(); } \
            v4 = *(const u32x2*)(Vx + cb_ + voff); SB_(); rv = *(const float*)(Rx + rb_ + roff); SB_(); tl = *(const float*)(Tx + rb_ + roff); SB_(); } while (0)
#define SCAN_STAGE(bf, k4, q4, v4, rv, tl) do { LAS unsigned char* B_ = lds + (bf) * BUFB; \
            _Pragma("unroll") for (int i = 0; i < 2; ++i) { const int pc = tid + 512 * i; *(LAS u32x4*)(B_ + ((pc >> 4) * QST + (pc & 15) * 8) * 2) = q4[i]; *(LAS u32x4*)(B_ + OFF_KS + ((pc >> 4) * QST + (pc & 15) * 8) * 2) = k4[i]; } \
            *(LAS u32x2*)(B_ + OFF_V + ((tid >> 3) * VST + (tid & 7) * 4) * 2) = v4; \
            if (tid < 128) { scs[(bf) * 128 + tid] = __expf(rv + tailp); tailp = tl; } } while (0)
#define SCAN_MAT(bf, n) do { LAS unsigned char* B_ = lds + (bf) * BUFB; LAS bf16_t* Qs = (LAS bf16_t*)B_; LAS bf16_t* Ks = (LAS bf16_t*)(B_ + OFF_KS); LAS bf16_t* Vs = (LAS bf16_t*)(B_ + OFF_V); \
            _Pragma("unroll") for (int ti = 0; ti < 2; ++ti) { const int db = 2 * tb + ti; const float scv = scs[(bf) * 128 + 16 * db + ln]; S[ti] *= scv; \
                *(LAS u32x2*)(Sr + (16 * db + ln) * VST + 16 * eb + 4 * lq) = (u32x2){cvt_pk_bf16(S[ti][0], S[ti][1]), cvt_pk_bf16(S[ti][2], S[ti][3])}; } \
            bf16x8 Bq[4]; f32x4 pt[4]; \
            _Pragma("unroll") for (int ks = 0; ks < 4; ++ks) Bq[ks] = *(const LAS bf16x8*)(Qs + (16 * tb + ln) * QST + ks * 32 + lq * 8); \
            _Pragma("unroll") for (int sb = 0; sb < 4; ++sb) { pt[sb] = (f32x4){0.f, 0.f, 0.f, 0.f}; \
                if (sb <= tb) { f32x4 a = (f32x4){0.f, 0.f, 0.f, 0.f}; \
                    _Pragma("unroll") for (int ks = 0; ks < 4; ++ks) { const bf16x8 Ak = *(const LAS bf16x8*)(Ks + (16 * sb + ln) * QST + ks * 32 + lq * 8); a = MFMA16(Ak, Bq[ks], a); } \
                    if (sb == tb) { _Pragma("unroll") for (int i = 0; i < 4; ++i) if (4 * lq + i > ln) a[i] = 0.f; } \
                    pt[sb] = a; } } \
            SCAN_BAR(); \
            f32x4 o = (f32x4){0.f, 0.f, 0.f, 0.f}; \
            _Pragma("unroll") for (int ks = 0; ks < 4; ++ks) { const bf16x8 As = tr_pair(Sr, VST, 32 * ks + 8 * lq, 32 * ks + 8 * lq + 4, 16 * eb, ln); o = MFMA16(As, Bq[ks], o); } \
            _Pragma("unroll") for (int g = 0; g < 2; ++g) { if (2 * g <= tb) { \
                    const bf16x8 Av = tr_pair(Vs, VST, 32 * g + 4 * lq, 32 * g + 16 + 4 * lq, 16 * eb, ln); \
                    const u32x4 bp = {cvt_pk_bf16_mfma(pt[2 * g][0], pt[2 * g][1]), cvt_pk_bf16(pt[2 * g][2], pt[2 * g][3]), cvt_pk_bf16(pt[2 * g + 1][0], pt[2 * g + 1][1]), cvt_pk_bf16(pt[2 * g + 1][2], pt[2 * g + 1][3])}; \
                    o = MFMA16(Av, __builtin_bit_cast(bf16x8, bp), o); } } \
            { const int pos = 16 * tb + ln; const size_t row = (size_t)scan_cid((n), dir, b) * 64 + (dir ? 63 - pos : pos); \
              bf16_t* dst = ((n) >= 4) ? O + ((size_t)dir * NLAT + row) * 512 + h * 128 + es * 32 : Odummy + (size_t)pos * 512;     \
              *(u32x2*)(dst + 16 * eb + 4 * lq) = (u32x2){cvt_pk_bf16_mfma(o[0], o[1]), cvt_pk_bf16_mfma(o[2], o[3])}; } \
            _Pragma("unroll") for (int k2i = 0; k2i < 2; ++k2i) { const bf16x8 Av = tr_pair(Vs, VST, 32 * k2i + 8 * lq, 32 * k2i + 8 * lq + 4, 16 * eb, ln); \
                _Pragma("unroll") for (int ti = 0; ti < 2; ++ti) { const bf16x8 Bk = tr_pair(Ks, QST, 32 * k2i + 8 * lq, 32 * k2i + 8 * lq + 4, 16 * (2 * tb + ti), ln); S[ti] = MFMA16(Av, Bk, S[ti]); } } \
            } while (0)
        SCAN_LOAD(0, k4A, q4A, v4A, rvA, tlA); SCAN_LOAD(1, k4B, q4B, v4B, rvB, tlB); SCAN_LOAD(2, k4C, q4C, v4C, rvC, tlC); SCAN_LOAD(3, k4D, q4D, v4D, rvD, tlD);
        SCAN_STAGE(0, k4A, q4A, v4A, rvA, tlA); SCAN_LOAD(4, k4A, q4A, v4A, rvA, tlA);
        SCAN_BAR();
#pragma unroll 1
        for (int n0 = 0; n0 < 68; n0 += 4) {
            SCAN_STAGE(1, k4B, q4B, v4B, rvB, tlB); SCAN_LOAD(min(n0 + 5, 67), k4B, q4B, v4B, rvB, tlB); SCAN_MAT(0, n0); SCAN_BAR();
            SCAN_STAGE(0, k4C, q4C, v4C, rvC, tlC); SCAN_LOAD(min(n0 + 6, 67), k4C, q4C, v4C, rvC, tlC); SCAN_MAT(1, n0 + 1); SCAN_BAR();
            SCAN_STAGE(1, k4D, q4D, v4D, rvD, tlD); SCAN_LOAD(min(n0 + 7, 67), k4D, q4D, v4D, rvD, tlD); SCAN_MAT(0, n0 + 2); SCAN_BAR();
            SCAN_STAGE(0, k4A, q4A, v4A, rvA, tlA); SCAN_LOAD(min(n0 + 8, 67), k4A, q4A, v4A, rvA, tlA); SCAN_MAT(1, n0 + 3); SCAN_BAR();
        }
#undef SCAN_LOAD
#undef SCAN_STAGE
#undef SCAN_MAT
    }
}

__device__ void conv_phase(LAS unsigned char* lds, const Params& p) {
    const int tid = threadIdx.x, w = tid >> 6, lane = tid & 63;
    LAS float* wl = (LAS float*)lds;
    for (int i = tid; i < 32 * 128; i += NTHR) ((LAS f32x4*)wl)[i] = (i < 31 * 128) ? ((const f32x4*)p.conv_w)[i] : (f32x4){0.f, 0.f, 0.f, 0.f};
    __syncthreads();
    const bf16_t* Gp = (const bf16_t*)(p.ws + WS_G); const bf16_t* GAp = (const bf16_t*)(p.ws + WS_GA); const bf16_t* GBp = (const bf16_t*)(p.ws + WS_GB);
    const bf16_t* O = (const bf16_t*)p.out;
    bf16_t* A2 = (bf16_t*)(p.ws + WS_A);
    const int half = lane >> 5, ch0 = lane * 8;
    for (int it = blockIdx.x * 8 + w; it < 8192; it += gridDim.x * 8) {
        const int b = it >> 10, r0 = ((it >> 5) & 31) * 2, c0 = (it & 31) * 2;
        float acc[4][8];
        const char* Pb = (const char*)Gp;
        const int base = half ? r0 : c0;
        const unsigned stepB = (half ? 64u : 1u) * 1024u;
#pragma unroll 1
        for (int line = 0; line < 2; ++line) {
            const int tok0 = half ? (c0 + line) : (r0 + line) * 64;
            const unsigned offb = (unsigned)((b * 4096 + tok0) * 512 + ch0) * 2u;
            asm volatile("" ::: "memory");
            float cur[2][8];
#pragma unroll
            for (int a = 0; a < 2; ++a)
#pragma unroll
                for (int c = 0; c < 8; ++c) cur[a][c] = 0.f;
            float Wp[8];
#pragma unroll
            for (int c = 0; c < 8; ++c) Wp[c] = 0.f;
#pragma unroll 1
            for (int hb = 0; hb < 4; ++hb) {
                u32x4 raw[8];
#pragma unroll
                for (int q = 0; q < 8; ++q) {
                    const int xx = base - 15 + hb * 8 + q;
                    const int xc = min(max(xx, 0), 63);
                    const u32x4 r = *(const u32x4*)(Pb + (offb + (unsigned)xc * stepB));
                    const bool ok = (xx == xc);
                    raw[q] = (u32x4){ok ? r[0] : 0u, ok ? r[1] : 0u, ok ? r[2] : 0u, ok ? r[3] : 0u};
                }
                const LAS float* wrow = wl + hb * 8 * 512 + ch0;
#pragma unroll
                for (int q = 0; q < 8; ++q) {
                    const float in[8] = {bf_lo(raw[q][0]), bf_hi(raw[q][0]), bf_lo(raw[q][1]), bf_hi(raw[q][1]), bf_lo(raw[q][2]), bf_hi(raw[q][2]), bf_lo(raw[q][3]), bf_hi(raw[q][3])};
                    const f32x4 wa = *(const LAS f32x4*)(wrow + q * 512), wb = *(const LAS f32x4*)(wrow + q * 512 + 4);
                    const float Wc[8] = {wa[0], wa[1], wa[2], wa[3], wb[0], wb[1], wb[2], wb[3]};
#pragma unroll
                    for (int c = 0; c < 8; ++c) { cur[0][c] += Wc[c] * in[c]; cur[1][c] += Wp[c] * in[c]; Wp[c] = Wc[c]; }
                }
            }
#pragma unroll
            for (int j = 0; j < 2; ++j)
#pragma unroll
                for (int c = 0; c < 8; ++c) { if (line == 0) acc[j][c] = cur[j][c]; else acc[2 + j][c] = cur[j][c]; }
        }
        float cbv[8], lg[8], lbv[8], hg[8];
        { const f32x4 a0 = *(const f32x4*)(p.conv_b + ch0), a1 = *(const f32x4*)(p.conv_b + ch0 + 4), b0 = *(const f32x4*)(p.conv_ln_g + ch0), b1 = *(const f32x4*)(p.conv_ln_g + ch0 + 4);
          const f32x4 d0 = *(const f32x4*)(p.conv_ln_b + ch0), d1 = *(const f32x4*)(p.conv_ln_b + ch0 + 4), e0 = *(const f32x4*)(p.hgrn_norm_g + ch0), e1 = *(const f32x4*)(p.hgrn_norm_g + ch0 + 4);
#pragma unroll
          for (int c = 0; c < 4; ++c) { cbv[c] = a0[c]; cbv[4 + c] = a1[c]; lg[c] = b0[c]; lg[4 + c] = b1[c]; lbv[c] = d0[c]; lbv[4 + c] = d1[c]; hg[c] = e0[c]; hg[4 + c] = e1[c]; } }
#pragma unroll
        for (int lr = 0; lr < 2; ++lr)
#pragma unroll
            for (int lc = 0; lc < 2; ++lc) {
                const size_t token = (size_t)b * 4096 + (r0 + lr) * 64 + (c0 + lc);
                float v[8]; float s1 = 0.f, s2 = 0.f;
#pragma unroll
                for (int c = 0; c < 8; ++c) { v[c] = (half ? acc[lc * 2 + lr][c] : acc[lr * 2 + lc][c]) + cbv[c]; s1 += v[c]; s2 += v[c] * v[c]; }
#pragma unroll
                for (int m = 32; m >= 1; m >>= 1) { s1 += __shfl_xor(s1, m); s2 += __shfl_xor(s2, m); }
                const float mean = s1 * (1.f / 512.f), var = fmaxf(s2 * (1.f / 512.f) - mean * mean, 0.f), rstd = rsqrtf(var + EPS);
                const u32x4 gbr = *(const u32x4*)(GBp + token * 512 + ch0);
                const float gbv[8] = {bf_lo(gbr[0]), bf_hi(gbr[0]), bf_lo(gbr[1]), bf_hi(gbr[1]), bf_lo(gbr[2]), bf_hi(gbr[2]), bf_lo(gbr[3]), bf_hi(gbr[3])};
                float y[8];
#pragma unroll
                for (int c = 0; c < 8; ++c) { const float t = (v[c] - mean) * rstd * lg[c] + lbv[c]; y[c] = siluf_(t) * gbv[c]; }
                u32x4 ob = {cvt_pk_bf16(y[0], y[1]), cvt_pk_bf16(y[2], y[3]), cvt_pk_bf16(y[4], y[5]), cvt_pk_bf16(y[6], y[7])};
                *(u32x4*)(A2 + token * 1024 + 512 + ch0) = ob;
                const u32x4 fo = *(const u32x4*)(O + token * 512 + ch0), bo = *(const u32x4*)(O + ((size_t)NLAT + token) * 512 + ch0);
                float ov[8]; float ss = 0.f;
#pragma unroll
                for (int c = 0; c < 4; ++c) { ov[2 * c] = bf_lo(fo[c]) + bf_lo(bo[c]); ov[2 * c + 1] = bf_hi(fo[c]) + bf_hi(bo[c]); }
#pragma unroll
                for (int c = 0; c < 8; ++c) ss += ov[c] * ov[c];
                ss += __shfl_xor(ss, 1); ss += __shfl_xor(ss, 2); ss += __shfl_xor(ss, 4); ss += __shfl_xor(ss, 8);
                const float rn = rsqrtf(ss * (1.f / 128.f) + EPS);
                const u32x4 gar = *(const u32x4*)(GAp + token * 512 + ch0);
                const float gav[8] = {bf_lo(gar[0]), bf_hi(gar[0]), bf_lo(gar[1]), bf_hi(gar[1]), bf_lo(gar[2]), bf_hi(gar[2]), bf_lo(gar[3]), bf_hi(gar[3])};
                float z[8];
#pragma unroll
                for (int c = 0; c < 8; ++c) z[c] = ov[c] * rn * hg[c] * gav[c];
                u32x4 oa = {cvt_pk_bf16(z[0], z[1]), cvt_pk_bf16(z[2], z[3]), cvt_pk_bf16(z[4], z[5]), cvt_pk_bf16(z[6], z[7])};
                *(u32x4*)(A2 + token * 1024 + ch0) = oa;
            }
    }
}

__device__ void final_phase(const Params& p) {
    const int tid = threadIdx.x, w = tid >> 6, lane = tid & 63;
    const float* modp = (const float*)(p.ws + WS_MODP);
    const bf16_t* Y = (const bf16_t*)(p.ws + WS_QF);
    const int rows_per = NLAT / gridDim.x;
    for (int r0 = blockIdx.x * rows_per; r0 < NLAT; r0 += gridDim.x * rows_per) {
        const int rend = min(r0 + rows_per, NLAT);
        int curb = -1; f32x4 gt[4], g[4];
#pragma unroll
        for (int c = 0; c < 4; ++c) { g[c] = *(const f32x4*)(p.final_norm_g + c * 256 + lane * 4); gt[c] = (f32x4){0.f, 0.f, 0.f, 0.f}; }
        for (int row = r0 + w * 2; row < rend; row += 16) {
            const int b = row >> 12;
            if (b != curb) { curb = b;
#pragma unroll
                for (int c = 0; c < 4; ++c) { f32x4 t = *(const f32x4*)(p.b_mod + 2048 + c * 256 + lane * 4);
#pragma unroll
                    for (int q = 0; q < 4; ++q) t += *(const f32x4*)(modp + (q * 9 + b) * 3072 + 2048 + c * 256 + lane * 4);
                    gt[c] = t; } }
            const float* xp = p.x + (size_t)row * 1024; const bf16_t* yp = Y + (size_t)row * 1024; float* op = p.out + (size_t)row * 1024;
            f32x4 h0[4], h1[4]; float s0 = 0.f, s1 = 0.f;
#pragma unroll
            for (int c = 0; c < 4; ++c) {
                const f32x4 x0 = *(const f32x4*)(xp + c * 256 + lane * 4), x1 = *(const f32x4*)(xp + 1024 + c * 256 + lane * 4);
                const u32x2 y0 = *(const u32x2*)(yp + c * 256 + lane * 4), y1 = *(const u32x2*)(yp + 1024 + c * 256 + lane * 4);
                h0[c] = x0 + gt[c] * (f32x4){bf_lo(y0[0]), bf_hi(y0[0]), bf_lo(y0[1]), bf_hi(y0[1])};
                h1[c] = x1 + gt[c] * (f32x4){bf_lo(y1[0]), bf_hi(y1[0]), bf_lo(y1[1]), bf_hi(y1[1])};
                s0 += h0[c][0] * h0[c][0] + h0[c][1] * h0[c][1] + h0[c][2] * h0[c][2] + h0[c][3] * h0[c][3];
                s1 += h1[c][0] * h1[c][0] + h1[c][1] * h1[c][1] + h1[c][2] * h1[c][2] + h1[c][3] * h1[c][3];
            }
#pragma unroll
            for (int m = 32; m >= 1; m >>= 1) { s0 += __shfl_xor(s0, m); s1 += __shfl_xor(s1, m); }
            const float rs0 = rsqrtf(s0 * (1.f / 1024.f) + EPS), rs1 = rsqrtf(s1 * (1.f / 1024.f) + EPS);
#pragma unroll
            for (int c = 0; c < 4; ++c) { *(f32x4*)(op + c * 256 + lane * 4) = h0[c] * rs0 * g[c]; *(f32x4*)(op + 1024 + c * 256 + lane * 4) = h1[c] * rs1 * g[c]; }
        }
    }
}

__global__ void __launch_bounds__(NTHR, 2) hymba_fwd(Params p) {
    extern __shared__ __attribute__((aligned(16))) unsigned char lds_raw[];
    LAS unsigned char* lds = (LAS unsigned char*)lds_raw;
    const int lo = p.ph_lo, hi = p.ph_hi;
#define IN(k) (lo <= (k) && (k) < hi)
#if N_LAUNCHES == 1
    volatile LAS unsigned* bst = (volatile LAS unsigned*)(lds + 131072);
    if (threadIdx.x < 4) bst[threadIdx.x] = 0u;
    __syncthreads();
    const XcdBarrier bar = xcd_barrier_post((unsigned*)(p.ws + WS_BAR), bst);
#define SEAM(k) do { if (IN(k) && IN((k) + 1)) xcd_barrier(bar); } while (0)
#else
#define SEAM(k) do { } while (0)
#endif
#ifndef DUP_PHASE
#define DUP_PHASE -1
#endif
    if (IN(0)) phase0(lds, p, 0, 192 + 1280);
    SEAM(0);
    if (IN(1)) phase1(lds, p);
    SEAM(1);
    if (IN(2)) {
        pg8::Gemm g{(const bf16_t*)(p.ws + WS_A), (const bf16_t*)(p.ws + WS_WIN), NROWS, 4096, 1024};
        pg8::InOrder S; S.init(NLAT, 4096, gridDim.x, blockIdx.x);
        EpiIn E{p.ws, p.lb_logits};
#pragma unroll 1
        for (int rep = 0; rep < (DUP_PHASE == 2 ? 2 : 1); ++rep) pg8::gemm_phase<EpiIn, pg8::InOrder>(lds, g, S, E);
    }
    SEAM(2);
    if (IN(3)) {
#pragma unroll 1
        for (int rep = 0; rep < (DUP_PHASE == 3 ? 2 : 1); ++rep) scan_phase(lds, p);
    }
    SEAM(3);
    if (IN(4)) { conv_phase(lds, p); if (DUP_PHASE == 4) { __syncthreads(); conv_phase(lds, p); } }
    SEAM(4);
    if (IN(5)) {
        pg8::Gemm g{(const bf16_t*)(p.ws + WS_A), (const bf16_t*)(p.ws + WS_WOUT), NLAT, 1024, 1024};
        pg8::StaticOrder S; S.init(NLAT, 1024, gridDim.x, blockIdx.x);
        EpiOut E{(bf16_t*)(p.ws + WS_QF)};
#pragma unroll 1
        for (int rep = 0; rep < (DUP_PHASE == 5 ? 2 : 1); ++rep) pg8::gemm_phase<EpiOut, pg8::StaticOrder>(lds, g, S, E);
    }
    SEAM(5);
    if (IN(6)) final_phase(p);
}

extern "C" void kernel_launch(void* const* d_in, const int* in_sizes, int n_in, void* d_out, int out_size, void* d_ws, size_t ws_size, hipStream_t stream) {
    static int grid = 0;
    if (grid == 0) {
        int dev = 0, cus = 0, per_cu = 0;
        hipGetDevice(&dev);
        hipDeviceGetAttribute(&cus, hipDeviceAttributeMultiprocessorCount, dev);
        hipFuncSetAttribute((const void*)hymba_fwd, hipFuncAttributeMaxDynamicSharedMemorySize, LDS_BYTES);
        hipOccupancyMaxActiveBlocksPerMultiprocessor(&per_cu, (const void*)hymba_fwd, NTHR, LDS_BYTES);
        if (per_cu < 1) { fprintf(stderr, "kernel_launch: occupancy query says %d blocks/CU\n", per_cu); per_cu = 1; }
        grid = cus * per_cu;
        if (ws_size < WS_END) { fprintf(stderr, "kernel_launch: workspace too small (%zu < %zu)\n", ws_size, (size_t)WS_END); grid = -1; }
    }
    if (grid < 0) return;
    Params p{};
    p.x = (const float*)d_in[0]; p.c = (const float*)d_in[1]; p.ctx = (const float*)d_in[2]; p.c_ctx = (const float*)d_in[3]; p.norm_g = (const float*)d_in[4];
    p.w_mod = (const float*)d_in[5]; p.b_mod = (const float*)d_in[6]; p.w_in = (const float*)d_in[7]; p.lb_logits = (const float*)d_in[8]; p.hgrn_norm_g = (const float*)d_in[9];
    p.conv_w = (const float*)d_in[10]; p.conv_b = (const float*)d_in[11]; p.conv_ln_g = (const float*)d_in[12]; p.conv_ln_b = (const float*)d_in[13]; p.w_out = (const float*)d_in[14];
    p.final_norm_g = (const float*)d_in[15];
    p.out = (float*)d_out; p.ws = (unsigned char*)d_ws;
#if N_LAUNCHES == 1
    p.ph_lo = 0; p.ph_hi = 7;
    hipMemsetAsync((unsigned char*)d_ws + WS_BAR, 0, XCD_BAR_WORDS * 4, stream);
    void* args[] = {&p};
    hipError_t e = hipLaunchCooperativeKernel((const void*)hymba_fwd, dim3(grid), dim3(NTHR), args, LDS_BYTES, stream);
    if (e != hipSuccess) fprintf(stderr, "cooperative launch failed: %s (grid %d)\n", hipGetErrorString(e), grid);
#else
    for (int ph = 0; ph < 7; ++ph) { p.ph_lo = ph; p.ph_hi = ph + 1; hipLaunchKernelGGL(hymba_fwd, dim3(grid), dim3(NTHR), LDS_BYTES, stream, p); }
#endif
}
```

```cpp
#include <hip/hip_runtime.h>
#include <hip/hip_cooperative_groups.h>
#include <cstdio>
namespace cg = cooperative_groups;

#ifndef N_LAUNCHES
#define N_LAUNCHES 1
#endif

#define LAS __attribute__((address_space(3)))
typedef unsigned short bf16_t;
typedef short bf16x8 __attribute__((ext_vector_type(8)));
typedef float f32x4 __attribute__((ext_vector_type(4)));
typedef float f32x2 __attribute__((ext_vector_type(2)));
typedef unsigned u32x4 __attribute__((ext_vector_type(4)));
typedef unsigned u32x2 __attribute__((ext_vector_type(2)));

constexpr int NTHR = 512;
constexpr int DM = 1024, NLAT = 32768, NROWS = 34816;
constexpr int NCHUNK = NROWS / 64;
constexpr float EPS = 1e-6f;
constexpr int LDS_BYTES = 131072 + 16;

constexpr size_t WS_WIN = 0;
constexpr size_t WS_WOUT = 8388608;
constexpr size_t WS_MODP = 10485760;
constexpr size_t WS_RSS = 11010048;
constexpr size_t WS_BAR = 13107200;
constexpr size_t WS_A = 13631488;
constexpr size_t SZ_S = (size_t)NROWS * 512 * 2, SZ_L = (size_t)NLAT * 512 * 2;
constexpr size_t WS_QF = WS_A + (size_t)NROWS * 1024 * 2;
constexpr size_t WS_QB = WS_QF + SZ_S;
constexpr size_t WS_KF = WS_QB + SZ_S;
constexpr size_t WS_KB = WS_KF + SZ_S;
constexpr size_t WS_V = WS_KB + SZ_S;
constexpr size_t WS_GA = WS_V + SZ_S;
constexpr size_t WS_G = WS_GA + SZ_L;
constexpr size_t WS_GB = WS_G + SZ_L;
constexpr size_t WS_RT = WS_GB + SZ_L;
constexpr size_t WS_END = WS_RT + (size_t)2 * 2 * NCHUNK * 512 * 4;

struct Params {
    const float *x, *c, *ctx, *c_ctx, *norm_g, *w_mod, *b_mod, *w_in, *lb_logits, *hgrn_norm_g, *conv_w, *conv_b, *conv_ln_g, *conv_ln_b, *w_out, *final_norm_g;
    float* out; unsigned char* ws; int ph_lo, ph_hi;
};

__device__ __forceinline__ unsigned cvt_pk_bf16(float lo, float hi) { unsigned r; asm volatile("v_cvt_pk_bf16_f32 %0, %1, %2" : "=v"(r) : "v"(lo), "v"(hi)); return r; }
__device__ __forceinline__ unsigned cvt_pk_bf16_mfma(float lo, float hi) { unsigned r; asm volatile("s_nop 15\n\ts_nop 7\n\tv_cvt_pk_bf16_f32 %0, %1, %2" : "=v"(r) : "v"(lo), "v"(hi)); return r; }
__device__ __forceinline__ float bf_lo(unsigned u) { return __uint_as_float(u << 16); }
__device__ __forceinline__ float bf_hi(unsigned u) { return __uint_as_float(u & 0xffff0000u); }
__device__ __forceinline__ float sigmoidf_(float v) { return __builtin_amdgcn_rcpf(1.f + __expf(-v)); }
__device__ __forceinline__ float siluf_(float v) { return v * __builtin_amdgcn_rcpf(1.f + __expf(-v)); }


#define XB_TMO      128
#define XB_XCNT(j)  (256  + 64 * (j))
#define XB_XSUB(j)  (1280 + 64 * (j))
#define XB_XGEN(j)  (2304 + 64 * (j))
#define XB_TOP      3328
#define XB_TOPGEN   3392
#define XCD_BAR_WORDS 3456
#define XB_SPIN_CAP (1u << 18)
__device__ __forceinline__ unsigned xb_ld(unsigned* p)              { return __hip_atomic_load(p, __ATOMIC_RELAXED, __HIP_MEMORY_SCOPE_AGENT); }
__device__ __forceinline__ unsigned xb_add(unsigned* p, unsigned v) { return __hip_atomic_fetch_add(p, v, __ATOMIC_RELAXED, __HIP_MEMORY_SCOPE_AGENT); }
__device__ __forceinline__ unsigned xb_xcc_id() { return (unsigned)__builtin_amdgcn_s_getreg((3 << 11) | 20) & 0xFu; }
#define XB_SPIN(cond, bar) do { unsigned _sp = 0; while (cond) { __builtin_amdgcn_s_sleep(1); \
    if ((++_sp & 255u) == 0u) { if (xb_ld(&(bar)[XB_TMO])) break; if (_sp > XB_SPIN_CAP) { atomicAdd(&(bar)[XB_TMO], 1u); break; } } } } while (0)
struct XcdBarrier { unsigned* bar; unsigned x; volatile LAS unsigned* st; };
__device__ __forceinline__ XcdBarrier xcd_barrier_post(unsigned* bar, volatile LAS unsigned* st) {
    XcdBarrier b; b.bar = bar; b.x = xb_xcc_id(); b.st = st;
    if (threadIdx.x == 0) (void)xb_add(&bar[XB_XCNT(b.x)], 1u);
    return b;
}
__device__ __forceinline__ void xcd_barrier_complete(unsigned* bar, unsigned x, unsigned& nloc, unsigned& nx) {
    const unsigned G = gridDim.x * gridDim.y * gridDim.z;
    unsigned sum, cnt, mine, sp = 0u;
    for (;;) {
        sum = 0u; cnt = 0u; mine = 0u;
#pragma unroll
        for (unsigned j = 0; j < 16; ++j) { const unsigned c = xb_ld(&bar[XB_XCNT(j)]); sum += c; cnt += (c > 0u) ? 1u : 0u; mine = (j == x) ? c : mine; }
        if (sum == G) break;
        __builtin_amdgcn_s_sleep(1);
        if ((++sp & 255u) == 0u) { if (xb_ld(&bar[XB_TMO])) break; if (sp > XB_SPIN_CAP) { atomicAdd(&bar[XB_TMO], 1u); break; } }
    }
    nloc = mine > 0u ? mine : 1u; nx = cnt > 0u ? cnt : 1u;
}
__device__ __forceinline__ void xcd_barrier(const XcdBarrier& b) {
    asm volatile("s_waitcnt vmcnt(0)" ::: "memory");
    __syncthreads();
    if (threadIdx.x == 0) {
        unsigned* bar = b.bar;
        __builtin_amdgcn_s_waitcnt(0);
        unsigned nloc = b.st[0], nx = b.st[1];
        if (nloc == 0u) { xcd_barrier_complete(bar, b.x, nloc, nx); b.st[0] = nloc; b.st[1] = nx; }
        const unsigned old = xb_add(&bar[XB_XSUB(b.x)], 1u);
        const unsigned gen = old / nloc;
        if (old + 1u == (gen + 1u) * nloc) {
            __builtin_amdgcn_fence(__ATOMIC_RELEASE, "agent");
            asm volatile("s_waitcnt vmcnt(0)" ::: "memory");
            const unsigned og = xb_add(&bar[XB_TOP], 1u);
            const unsigned tg = og / nx;
            if (og + 1u == (tg + 1u) * nx) xb_add(&bar[XB_TOPGEN], 1u);
            else XB_SPIN(xb_ld(&bar[XB_TOPGEN]) == tg, bar);
            __builtin_amdgcn_fence(__ATOMIC_ACQUIRE, "agent");
            xb_add(&bar[XB_XGEN(b.x)], 1u);
            asm volatile("s_waitcnt vmcnt(0)" ::: "memory");
        } else {
            XB_SPIN(xb_ld(&bar[XB_XGEN(b.x)]) == gen, bar);
            __builtin_amdgcn_fence(__ATOMIC_ACQUIRE, "agent");
            asm volatile("s_waitcnt vmcnt(0)" ::: "memory");
        }
    }
    __syncthreads();
}

namespace pg8 {
constexpr int BM = 256, BK = 64, HALF = 128, HTB = HALF * BK * 2, STAGE_BYTES = 8 * HTB, NXCD = 8, WGM = 8;
__host__ __device__ __forceinline__ int lds_byte(int r, int c) { const int st = (r >> 4) * 2 + (c >> 5), rr = r & 15, cc = c & 31, ob = rr * 64 + cc * 2; return st * 1024 + (ob ^ (((ob >> 9) & 1) << 5)); }
__host__ __device__ __forceinline__ void stage_rc(int b, int& R, int& C) { const int st = b / 1024, sb = b % 1024, swz = sb ^ (((sb >> 9) & 1) << 5); R = (st >> 1) * 16 + swz / 64; C = (st & 1) * 32 + (swz % 64) / 2; }
__host__ __device__ __forceinline__ int perm32(int rho) { const int n = rho >> 4, i = rho & 15; return 8 * (i >> 2) + 4 * n + (i & 3); }
struct Unit { int pm, pn; };
struct Gemm { const bf16_t* A; const bf16_t* Bt; int M, N, K; };
struct StaticOrder {
    int nM, nN, nwg, G, c;
    __device__ void init(int M, int N, int G_, int c_) { nM = M / BM; nN = N / BM; nwg = nM * nN; G = G_; c = c_; }
    __device__ bool map(int L, Unit& u) const {
        int wgid = L; { const int q = nwg / NXCD, r = nwg % NXCD, xcd = wgid % NXCD, off = wgid / NXCD; wgid = (xcd < r ? xcd * (q + 1) : r * (q + 1) + (xcd - r) * q) + off; }
        const int nig = WGM * nN, gid = wgid / nig, fm = gid * WGM, gsz = (nM - fm) < WGM ? (nM - fm) : WGM;
        u.pm = fm + ((wgid % nig) % gsz); u.pn = (wgid % nig) / gsz; return true;
    }
    __device__ bool next(int i, Unit& u) const { const long L = (long)i * G + c; if (L >= nwg) return false; return map((int)L, u); }
};
struct InOrder : StaticOrder {
    __device__ bool next(int i, Unit& u) const {
        const long L = (long)i * G + c;
        if (L < nwg) return map((int)L, u);
        const int k = (int)(L - nwg); if (k >= 64) return false;
        u.pm = 128 + (k >> 3); u.pn = k & 7; return true;
    }
};

template <class Epi, class Sched>
__device__ __forceinline__ void gemm_phase(LAS unsigned char* lds, const Gemm g, const Sched& S, const Epi& E) {
    const int tid = threadIdx.x, wid = __builtin_amdgcn_readfirstlane(tid >> 6), lane = tid & 63, wr = wid >> 2, wc = wid & 3, fr = lane & 15, fq = lane >> 4;
    const int K = g.K, nt = K / BK;
    unsigned voffA[2], voffB[2];
#pragma unroll
    for (int i = 0; i < 2; ++i) { int R, C; stage_rc(tid * 16 + i * 8192, R, C); const int Rb = Epi::PERM ? ((R & ~31) + perm32(R & 31)) : R;
        voffA[i] = (unsigned)(R * K + C) * 2u; voffB[i] = (unsigned)(Rb * K + C) * 2u; }
    const size_t kstep = (size_t)(BK * 2);
    const size_t hstep = (size_t)HALF * K * 2;
    const size_t tstep = 2 * hstep;
    const unsigned ldsw = (unsigned)wid * 1024u;
    const int aoff = lds_byte(wr * 64 + fr, fq * 8), boff = lds_byte(wc * 32 + fr, fq * 8);
#define PG8_SA(b, h) (((b) * 2 + (h)) * HTB)
#define PG8_SB(b, h) ((4 + (b) * 2 + (h)) * HTB)
#define PG8_STAGE(bufoff, gbase, voff) do { _Pragma("unroll") for (int _i = 0; _i < 2; ++_i) \
        __builtin_amdgcn_global_load_lds((const unsigned*)((const char*)(gbase) + (voff)[_i]), (LAS unsigned*)(lds + (bufoff) + ldsw + _i * 8192), 16, 0, 0); } while (0)
#define PG8_LDA(dst, b, h) do { _Pragma("unroll") for (int m = 0; m < 4; ++m) _Pragma("unroll") for (int k = 0; k < 2; ++k) dst[m][k] = *(const LAS bf16x8*)(lds + PG8_SA(b, h) + aoff + m * 2048 + k * 1024); } while (0)
#define PG8_LDB(dst, b, h) do { _Pragma("unroll") for (int n = 0; n < 2; ++n) _Pragma("unroll") for (int k = 0; k < 2; ++k) dst[n][k] = *(const LAS bf16x8*)(lds + PG8_SB(b, h) + boff + n * 2048 + k * 1024); } while (0)
#define PG8_MMA(ai, bj, At, Bt) do { __builtin_amdgcn_s_setprio(1); _Pragma("unroll") for (int m = 0; m < 4; ++m) _Pragma("unroll") for (int n = 0; n < 2; ++n) _Pragma("unroll") for (int k = 0; k < 2; ++k) \
        acc[ai][bj][m][n] = __builtin_amdgcn_mfma_f32_16x16x32_bf16(Bt[n][k], At[m][k], acc[ai][bj][m][n], 0, 0, 0); __builtin_amdgcn_s_setprio(0); } while (0)
#define PG8_WAIT_V(n) asm volatile("s_waitcnt vmcnt(" #n ")" ::: "memory")
#define PG8_WAIT_L(n) asm volatile("s_waitcnt lgkmcnt(" #n ")" ::: "memory")
#define PG8_BAR __builtin_amdgcn_s_barrier()
#define PG8_SCHED __builtin_amdgcn_sched_barrier(0)
    Unit cur, nxt; int ui = 0;
    if (!S.next(0, cur)) return;
    f32x4 acc[2][2][4][2];
#pragma unroll
    for (int a = 0; a < 2; ++a)
#pragma unroll
        for (int b = 0; b < 2; ++b)
#pragma unroll
            for (int m = 0; m < 4; ++m)
#pragma unroll
                for (int n = 0; n < 2; ++n) acc[a][b][m][n] = (f32x4){0.f, 0.f, 0.f, 0.f};
    bf16x8 At[4][2], B0[2][2], B1[2][2];
    const char* cA = (const char*)g.A + (size_t)cur.pm * tstep; const char* cB = (const char*)g.Bt + (size_t)cur.pn * tstep;
    PG8_STAGE(PG8_SB(0, 0), cB, voffB); PG8_STAGE(PG8_SA(0, 0), cA, voffA); PG8_STAGE(PG8_SB(0, 1), cB + hstep, voffB); PG8_STAGE(PG8_SA(0, 1), cA + hstep, voffA);
    if (wr == 1) PG8_BAR;
    PG8_WAIT_V(4); PG8_BAR;
    PG8_STAGE(PG8_SB(1, 0), cB + kstep, voffB); PG8_STAGE(PG8_SA(1, 0), cA + kstep, voffA); PG8_STAGE(PG8_SB(1, 1), cB + hstep + kstep, voffB);
    PG8_WAIT_V(6); PG8_BAR;
    for (;;) {
        const bool has_next = S.next(ui + 1, nxt);
        const char* nA = has_next ? (const char*)g.A + (size_t)nxt.pm * tstep : cA; const char* nB = has_next ? (const char*)g.Bt + (size_t)nxt.pn * tstep : cB;
        for (int t = 0; t < nt; t += 2) {
            const bool last = (t == nt - 2);
            const char* a1 = cA + (size_t)(t + 1) * kstep;
            const char* a2 = last ? nA : cA + (size_t)(t + 2) * kstep; const char* b2 = last ? nB : cB + (size_t)(t + 2) * kstep;
            const char* a3 = a2 + kstep; const char* b3 = b2 + kstep;
            PG8_LDB(B0, 0, 0); PG8_SCHED; PG8_LDA(At, 0, 0); PG8_STAGE(PG8_SA(1, 1), a1 + hstep, voffA);
            PG8_WAIT_L(8); PG8_BAR; PG8_WAIT_L(0); PG8_MMA(0, 0, At, B0); PG8_BAR; PG8_SCHED;
            PG8_LDB(B1, 0, 1); PG8_STAGE(PG8_SB(0, 0), b2, voffB);
            PG8_BAR; PG8_WAIT_L(0); PG8_MMA(0, 1, At, B1); PG8_BAR;
            PG8_LDA(At, 0, 1); PG8_STAGE(PG8_SA(0, 0), a2, voffA);
            PG8_BAR; PG8_WAIT_L(0); PG8_MMA(1, 0, At, B0); PG8_BAR; PG8_SCHED;
            PG8_STAGE(PG8_SB(0, 1), b2 + hstep, voffB);
            PG8_WAIT_V(6); PG8_BAR; PG8_MMA(1, 1, At, B1); PG8_BAR;
            PG8_LDB(B0, 1, 0); PG8_SCHED; PG8_LDA(At, 1, 0); PG8_STAGE(PG8_SA(0, 1), a2 + hstep, voffA);
            PG8_WAIT_L(8); PG8_BAR; PG8_WAIT_L(0); PG8_MMA(0, 0, At, B0); PG8_BAR; PG8_SCHED;
            PG8_LDB(B1, 1, 1); PG8_STAGE(PG8_SB(1, 0), b3, voffB);
            PG8_BAR; PG8_WAIT_L(0); PG8_MMA(0, 1, At, B1); PG8_BAR;
            PG8_LDA(At, 1, 1); PG8_STAGE(PG8_SA(1, 0), a3, voffA);
            PG8_BAR; PG8_WAIT_L(0); PG8_MMA(1, 0, At, B0); PG8_BAR; PG8_SCHED;
            PG8_STAGE(PG8_SB(1, 1), b3 + hstep, voffB);
            PG8_WAIT_V(6); PG8_BAR; PG8_MMA(1, 1, At, B1); PG8_BAR;
        }
        E(acc, cur, wr, wc, fr, fq);
        if (!has_next) break;
#pragma unroll
        for (int a = 0; a < 2; ++a)
#pragma unroll
            for (int b = 0; b < 2; ++b)
#pragma unroll
                for (int m = 0; m < 4; ++m)
#pragma unroll
                    for (int n = 0; n < 2; ++n) acc[a][b][m][n] = (f32x4){0.f, 0.f, 0.f, 0.f};
        cur = nxt; cA = nA; cB = nB; ++ui;
    }
    PG8_WAIT_V(0);
    if (wr == 0) PG8_BAR;
    PG8_BAR;
#undef PG8_SA
#undef PG8_SB
#undef PG8_STAGE
#undef PG8_LDA
#undef PG8_LDB
#undef PG8_MMA
#undef PG8_WAIT_V
#undef PG8_WAIT_L
#undef PG8_BAR
#undef PG8_SCHED
}
}

template <int K> __device__ __forceinline__ float dpp_shr(float x) { return __int_as_float(__builtin_amdgcn_update_dpp(0, __float_as_int(x), 0x110 + K, 0xf, 0xf, true)); }
__device__ __forceinline__ float scan16(float x) { x += dpp_shr<1>(x); x += dpp_shr<2>(x); x += dpp_shr<4>(x); x += dpp_shr<8>(x); return x; }
__device__ __forceinline__ float clamp80(float x) { return fminf(fmaxf(x, -80.f), 80.f); }
struct EpiIn {
    static constexpr bool PERM = true;
    unsigned char* ws; const float* lb_logits;
    __device__ __forceinline__ void operator()(const f32x4 (&acc)[2][2][4][2], const pg8::Unit& u, int wr, int wc, int fr, int fq) const {
        asm volatile("s_nop 15\n\ts_nop 15\n\ts_nop 15\n\ts_nop 15" ::: "memory");
        const int row0 = u.pm * 256 + wr * 64 + fr, pn = u.pn;
        if (pn < 8) {
            bf16_t* QF = (bf16_t*)(ws + WS_QF); bf16_t* QB = (bf16_t*)(ws + WS_QB); bf16_t* KF = (bf16_t*)(ws + WS_KF); bf16_t* KB = (bf16_t*)(ws + WS_KB); bf16_t* V = (bf16_t*)(ws + WS_V);
            float* RT = (float*)(ws + WS_RT);
            const int ch0 = 64 * pn + 16 * wc + 4 * fq;
            float lbF[4], lbB[4];
#pragma unroll
            for (int j = 0; j < 4; ++j) { lbF[j] = 1.f / (1.f + __expf(lb_logits[1024 + ch0 + j] - lb_logits[ch0 + j])); lbB[j] = 1.f / (1.f + __expf(lb_logits[1536 + ch0 + j] - lb_logits[512 + ch0 + j])); }
#pragma unroll
            for (int ai = 0; ai < 2; ++ai) {
                const int rowc = u.pm * 256 + 128 * ai + 64 * wr;
                const int cid = rowc >> 6;
                unsigned oQF[4][2], oQB[4][2], oKF[4][2], oKB[4][2]; f32x4 rtv[4];
#pragma unroll
                for (int jp = 0; jp < 2; ++jp) {
                    float vQF[4][2], vQB[4][2], vKF[4][2], vKB[4][2];
#pragma unroll
                    for (int jj = 0; jj < 2; ++jj) {
                        const int j = 2 * jp + jj;
                        float lfF[4], kkF[4], lfB[4], kkB[4], pF[4], pB[4], tF[4], tB[4];
#pragma unroll
                        for (int m = 0; m < 4; ++m) {
                            { const float z = acc[ai][0][m][1][j]; const float e = __expf(fminf(-z, 30.f)); const float s = __builtin_amdgcn_rcpf(1.f + e); lfF[m] = __logf(lbF[j] + (1.f - lbF[j]) * s); kkF[m] = (1.f - lbF[j]) * e * s; }
                            { const float z = acc[ai][1][m][0][j]; const float e = __expf(fminf(-z, 30.f)); const float s = __builtin_amdgcn_rcpf(1.f + e); lfB[m] = __logf(lbB[j] + (1.f - lbB[j]) * s); kkB[m] = (1.f - lbB[j]) * e * s; }
                            pF[m] = scan16(lfF[m]); pB[m] = scan16(lfB[m]);
                            tF[m] = __int_as_float(__builtin_amdgcn_update_dpp(0, __float_as_int(pF[m]), 0x15F, 0xf, 0xf, true));
                            tB[m] = __int_as_float(__builtin_amdgcn_update_dpp(0, __float_as_int(pB[m]), 0x15F, 0xf, 0xf, true));
                        }
                        const float rF = tF[0] + tF[1], blF = rF + tF[2] + tF[3];
                        const float rB = tB[2] + tB[3], blB = rB + tB[0] + tB[1];
                        float cF = 0.f, cB = 0.f;
#pragma unroll
                        for (int m = 0; m < 4; ++m) {
                            const float bF = pF[m] + cF; cF += tF[m];
                            const float bB = blB - (pB[m] + cB) + lfB[m]; cB += tB[m];
                            const float xF = clamp80(bF - rF), xB = clamp80(bB - rB);
                            const float q = acc[ai][0][m][0][j];
                            vQF[m][jj] = q * __expf(xF); vKF[m][jj] = kkF[m] * __expf(-xF);
                            vQB[m][jj] = q * __expf(xB); vKB[m][jj] = kkB[m] * __expf(-xB);
                        }
                        rtv[0][j] = rF; rtv[1][j] = rB; rtv[2][j] = blF - rF; rtv[3][j] = blB - rB;
                    }
#pragma unroll
                    for (int m = 0; m < 4; ++m) { oQF[m][jp] = cvt_pk_bf16(vQF[m][0], vQF[m][1]); oQB[m][jp] = cvt_pk_bf16(vQB[m][0], vQB[m][1]); oKF[m][jp] = cvt_pk_bf16(vKF[m][0], vKF[m][1]); oKB[m][jp] = cvt_pk_bf16(vKB[m][0], vKB[m][1]); }
                }
                if (fr == 0) {
#pragma unroll
                    for (int t = 0; t < 4; ++t) *(f32x4*)(RT + (size_t)t * NCHUNK * 512 + (size_t)cid * 512 + ch0) = rtv[t];
                }
#pragma unroll
                for (int mp = 0; mp < 2; ++mp) {
                    const int a = 2 * mp, bb = 2 * mp + 1, odd = fq & 1;
                    const size_t off = (size_t)(rowc + 16 * (odd ? bb : a) + fr) * 512 + (ch0 - 4 * odd);
                    const f32x4 va = acc[ai][1][a][1], vb = acc[ai][1][bb][1];
                    const unsigned oVa0 = cvt_pk_bf16(va[0], va[1]), oVa1 = cvt_pk_bf16(va[2], va[3]), oVb0 = cvt_pk_bf16(vb[0], vb[1]), oVb1 = cvt_pk_bf16(vb[2], vb[3]);
                    asm volatile("s_nop 1" ::: "memory");
#define WIDE_ST(P, x0a, x1a, x0b, x1b) do { const u32x2 s0 = __builtin_amdgcn_permlane16_swap((x0a), (x0b), false, false), s1 = __builtin_amdgcn_permlane16_swap((x1a), (x1b), false, false); \
                        *(u32x4*)((P) + off) = (u32x4){s0[0], s1[0], s0[1], s1[1]}; } while (0)
                    WIDE_ST(QF, oQF[a][0], oQF[a][1], oQF[bb][0], oQF[bb][1]); WIDE_ST(QB, oQB[a][0], oQB[a][1], oQB[bb][0], oQB[bb][1]);
                    WIDE_ST(KF, oKF[a][0], oKF[a][1], oKF[bb][0], oKF[bb][1]); WIDE_ST(KB, oKB[a][0], oKB[a][1], oKB[bb][0], oKB[bb][1]);
                    WIDE_ST(V, oVa0, oVa1, oVb0, oVb1);
#undef WIDE_ST
                }
            }
        } else if (pn >= 10 && pn <= 13) {
            bf16_t* G = (bf16_t*)(ws + WS_G);
            const int chb = 128 * (pn - 10) + 16 * wc + 4 * fq;
            const int odd = fq & 1;
#pragma unroll
            for (int ai = 0; ai < 2; ++ai)
#pragma unroll
                for (int mp = 0; mp < 2; ++mp) {
                    const size_t row = (size_t)(row0 + ai * 128 + (2 * mp + odd) * 16);
#pragma unroll
                    for (int bj = 0; bj < 2; ++bj) {
                        const f32x4 ua = acc[ai][bj][2 * mp][0], ga = acc[ai][bj][2 * mp][1], ub = acc[ai][bj][2 * mp + 1][0], gb = acc[ai][bj][2 * mp + 1][1];
                        const unsigned a0 = cvt_pk_bf16(ua[0] * sigmoidf_(ga[0]), ua[1] * sigmoidf_(ga[1])), a1 = cvt_pk_bf16(ua[2] * sigmoidf_(ga[2]), ua[3] * sigmoidf_(ga[3]));
                        const unsigned b0 = cvt_pk_bf16(ub[0] * sigmoidf_(gb[0]), ub[1] * sigmoidf_(gb[1])), b1 = cvt_pk_bf16(ub[2] * sigmoidf_(gb[2]), ub[3] * sigmoidf_(gb[3]));
                        asm volatile("s_nop 1" ::: "memory");
                        const u32x2 s0 = __builtin_amdgcn_permlane16_swap(a0, b0, false, false), s1 = __builtin_amdgcn_permlane16_swap(a1, b1, false, false);
                        *(u32x4*)(G + row * 512 + (chb - 4 * odd) + 64 * bj) = (u32x4){s0[0], s1[0], s0[1], s1[1]};
                    }
                }
        } else {
            bf16_t* D = (bf16_t*)(ws + (pn < 10 ? WS_GA : WS_GB));
            const int colb = 256 * (pn < 10 ? pn - 8 : pn - 14) + 32 * wc + 8 * fq;
#pragma unroll
            for (int ai = 0; ai < 2; ++ai)
#pragma unroll
                for (int m = 0; m < 4; ++m) {
                    const size_t row = (size_t)(row0 + ai * 128 + m * 16);
#pragma unroll
                    for (int bj = 0; bj < 2; ++bj) {
                        f32x4 v0 = acc[ai][bj][m][0], v1 = acc[ai][bj][m][1];
#pragma unroll
                        for (int j = 0; j < 4; ++j) { v0[j] = siluf_(v0[j]); v1[j] = siluf_(v1[j]); }
                        u32x4 o = {cvt_pk_bf16(v0[0], v0[1]), cvt_pk_bf16(v0[2], v0[3]), cvt_pk_bf16(v1[0], v1[1]), cvt_pk_bf16(v1[2], v1[3])};
                        *(u32x4*)(D + row * 512 + colb + 128 * bj) = o;
                    }
                }
        }
    }
};

struct EpiOut {
    static constexpr bool PERM = true;
    bf16_t* Y;
    __device__ __forceinline__ void operator()(const f32x4 (&acc)[2][2][4][2], const pg8::Unit& u, int wr, int wc, int fr, int fq) const {
        asm volatile("s_nop 15\n\ts_nop 15\n\ts_nop 15\n\ts_nop 15" ::: "memory");
        const int row0 = u.pm * 256 + wr * 64 + fr, col0 = u.pn * 256 + wc * 32 + 8 * fq;
#pragma unroll
        for (int ai = 0; ai < 2; ++ai)
#pragma unroll
            for (int m = 0; m < 4; ++m) {
                const size_t row = (size_t)(row0 + ai * 128 + m * 16);
#pragma unroll
                for (int bj = 0; bj < 2; ++bj) {
                    const f32x4 v0 = acc[ai][bj][m][0], v1 = acc[ai][bj][m][1];
                    u32x4 o = {cvt_pk_bf16(v0[0], v0[1]), cvt_pk_bf16(v0[2], v0[3]), cvt_pk_bf16(v1[0], v1[1]), cvt_pk_bf16(v1[2], v1[3])};
                    *(u32x4*)(Y + row * 1024 + col0 + 128 * bj) = o;
                }
            }
    }
};

__device__ void phase0(LAS unsigned char* lds, const Params& p, int it_lo, int it_hi) {
    const int tid = threadIdx.x;
    LAS float* fl = (LAS float*)lds;
    float* modp = (float*)(p.ws + WS_MODP);
    for (int it = it_lo + blockIdx.x; it < it_hi; it += gridDim.x) {
        if (it < 192) {
            const int cc = it % 48, kq = it / 48;
            LAS float* sil = fl; LAS float* red = fl + 2304;
            for (int i = tid; i < 2304; i += NTHR) { const int j = i >> 8, k = kq * 256 + (i & 255); const float v = (j < 8) ? p.c[j * 1024 + k] : p.c_ctx[k]; sil[i] = siluf_(v); }
            __syncthreads();
            const int n = tid & 63, ks = tid >> 6;
            const float* wp = p.w_mod + (size_t)(kq * 256 + ks * 32) * 3072 + cc * 64 + n;
            float a[9];
#pragma unroll
            for (int j = 0; j < 9; ++j) a[j] = 0.f;
#pragma unroll 8
            for (int kk = 0; kk < 32; ++kk) { const float w = wp[(size_t)kk * 3072];
#pragma unroll
                for (int j = 0; j < 9; ++j) a[j] += sil[j * 256 + ks * 32 + kk] * w; }
#pragma unroll
            for (int j = 0; j < 9; ++j) red[(ks * 9 + j) * 64 + n] = a[j];
            __syncthreads();
            for (int i = tid; i < 576; i += NTHR) { const int j = i >> 6, nn = i & 63; float s = 0.f;
#pragma unroll
                for (int k2 = 0; k2 < 8; ++k2) s += red[(k2 * 9 + j) * 64 + nn];
                modp[(kq * 9 + j) * 3072 + cc * 64 + nn] = s; }
            __syncthreads();
        } else {
            int t = it - 192; const float* W; bf16_t* WT; int N; bool isin;
            if (t < 1024) { W = p.w_in; WT = (bf16_t*)(p.ws + WS_WIN); N = 4096; isin = true; } else { t -= 1024; W = p.w_out; WT = (bf16_t*)(p.ws + WS_WOUT); N = 1024; isin = false; }
            const int kt = t & 15, nt = t >> 4;
            const int n = tid & 63, k0 = tid >> 6;
            const int ncol = nt * 64 + n; int src = ncol;
            if (isin && ncol < 2048) { const int pnn = ncol >> 8, cc = ncol & 255; const int type = ((cc >> 7) << 1) | ((cc >> 2) & 1); src = type * 512 + 64 * pnn + 16 * ((cc >> 5) & 3) + 4 * ((cc >> 3) & 3) + (cc & 3); }
            else if (isin && ncol >= 2560 && ncol < 3584) { const int mm = ncol - 2560, g = mm >> 3, i = mm & 7; src = (i < 4) ? 2560 + 4 * g + i : 3072 + 4 * g + (i - 4); }
#pragma unroll
            for (int ps = 0; ps < 8; ++ps) { const int k = ps * 8 + k0; fl[k * 65 + n] = W[(size_t)(kt * 64 + k) * N + src]; }
            __syncthreads();
            const int nn = tid >> 3, k8 = tid & 7;
            float v[8];
#pragma unroll
            for (int j = 0; j < 8; ++j) v[j] = fl[(k8 * 8 + j) * 65 + nn];
            u32x4 o = {cvt_pk_bf16(v[0], v[1]), cvt_pk_bf16(v[2], v[3]), cvt_pk_bf16(v[4], v[5]), cvt_pk_bf16(v[6], v[7])};
            *(u32x4*)(WT + (size_t)(nt * 64 + nn) * 1024 + kt * 64 + k8 * 8) = o;
            __syncthreads();
        }
    }
}

__device__ void phase1(LAS unsigned char* lds, const Params& p) {
    const int tid = threadIdx.x, w = tid >> 6, lane = tid & 63;
    LAS float* mv = (LAS float*)lds;
    const float* modp = (const float*)(p.ws + WS_MODP);
    bf16_t* A = (bf16_t*)(p.ws + WS_A);
    const int ngrp = NROWS / 8;
    const int g0 = (int)((long)blockIdx.x * ngrp / gridDim.x), g1 = (int)((long)(blockIdx.x + 1) * ngrp / gridDim.x);
    int curj = -1;
    for (int g = g0; g < g1; ++g) {
        const int row0 = g * 8; const int j = row0 < NLAT ? (row0 >> 12) : 8;
        if (j != curj) {
            __syncthreads();
            for (int i = tid; i < 1024; i += NTHR) { float sh = p.b_mod[i], sc = p.b_mod[1024 + i];
#pragma unroll
                for (int q = 0; q < 4; ++q) { sh += modp[(q * 9 + j) * 3072 + i]; sc += modp[(q * 9 + j) * 3072 + 1024 + i]; }
                mv[i] = p.norm_g[i] * (1.f + sc); mv[1024 + i] = sh; }
            __syncthreads(); curj = j;
        }
        const int row = row0 + w;
        const float* xr = row < NLAT ? p.x + (size_t)row * 1024 : p.ctx + (size_t)(row - NLAT) * 1024;
        f32x4 v[4]; float ss = 0.f;
#pragma unroll
        for (int c = 0; c < 4; ++c) { v[c] = *(const f32x4*)(xr + c * 256 + lane * 4); ss += v[c][0] * v[c][0] + v[c][1] * v[c][1] + v[c][2] * v[c][2] + v[c][3] * v[c][3]; }
#pragma unroll
        for (int m = 32; m >= 1; m >>= 1) ss += __shfl_xor(ss, m);
        const float rs = rsqrtf(ss * (1.f / 1024.f) + EPS);
#pragma unroll
        for (int c = 0; c < 4; ++c) { const int k = c * 256 + lane * 4; const f32x4 m0 = *(const LAS f32x4*)(mv + k), m1 = *(const LAS f32x4*)(mv + 1024 + k);
            const f32x4 a = v[c] * rs * m0 + m1; u32x2 o = {cvt_pk_bf16(a[0], a[1]), cvt_pk_bf16(a[2], a[3])}; *(u32x2*)(A + (size_t)row * 1024 + k) = o; }
    }
}

#define MFMA16(a, b, c) __builtin_amdgcn_mfma_f32_16x16x32_bf16((a), (b), (c), 0, 0, 0)
__device__ __forceinline__ int scan_cid(int n, int dir, int b) { return n < 4 ? 512 + b * 4 + (dir ? 3 - n : n) : b * 64 + (dir ? 67 - n : n - 4); }
#define SCAN_BAR() asm volatile("s_waitcnt lgkmcnt(0)\n\ts_barrier" ::: "memory")
#define SB_() __builtin_amdgcn_sched_barrier(0)
typedef short s16x4 __attribute__((ext_vector_type(4)));
__device__ __forceinline__ bf16x8 tr_pair(const LAS bf16_t* img, int stride, int r0a, int r0b, int c0, int ln) {
    const int q = ln >> 2, p = ln & 3;
    const s16x4 a = __builtin_amdgcn_ds_read_tr16_b64_v4i16((LAS s16x4*)(img + (r0a + q) * stride + c0 + 4 * p));
    const s16x4 b = __builtin_amdgcn_ds_read_tr16_b64_v4i16((LAS s16x4*)(img + (r0b + q) * stride + c0 + 4 * p));
    return __builtin_shufflevector(a, b, 0, 1, 2, 3, 4, 5, 6, 7);
}
__device__ void scan_phase(LAS unsigned char* lds, const Params& p) {
    const int tid = threadIdx.x, w = __builtin_amdgcn_readfirstlane(tid >> 6), lane = tid & 63, ln = lane & 15, lq = lane >> 4;
    constexpr int QST = 136, VST = 36;
    constexpr int OFF_KS = 17408, OFF_V = 34816, BUFB = 39424;
    LAS bf16_t* Sr = (LAS bf16_t*)(lds + 2 * BUFB);
    LAS float* scs = (LAS float*)(lds + 2 * BUFB + 9216);
    bf16_t* O = (bf16_t*)p.out;
    bf16_t* Odummy = (bf16_t*)(p.ws + WS_A) + (size_t)blockIdx.x * 64 * 512;
    const float* RT = (const float*)(p.ws + WS_RT);
    const int eb = w & 1, tb = w >> 1;
    for (int item = blockIdx.x; item < 256; item += gridDim.x) {
        const int seq = (item & 7) + 8 * (item >> 5), es = (item >> 3) & 3;
        const int dir = seq & 1, h = (seq >> 1) & 3, b = seq >> 3;
        const char* Qx = (const char*)((const bf16_t*)(p.ws + (dir ? WS_QB : WS_QF)) + h * 128);
        const char* Kx = (const char*)((const bf16_t*)(p.ws + (dir ? WS_KB : WS_KF)) + h * 128);
        const char* Vx = (const char*)((const bf16_t*)(p.ws + WS_V) + h * 128 + es * 32);
        const char* Rx = (const char*)(RT + (size_t)dir * NCHUNK * 512 + h * 128);
        const char* Tx = (const char*)(RT + (size_t)(2 + dir) * NCHUNK * 512 + h * 128);
        const unsigned qoff0 = (unsigned)((dir ? 63 - (tid >> 4) : (tid >> 4)) * 1024 + (tid & 15) * 16), qstep = dir ? (unsigned)-32768 : 32768u;
        const unsigned voff = (unsigned)((dir ? 63 - (tid >> 3) : (tid >> 3)) * 1024 + (tid & 7) * 8), roff = (unsigned)(tid & 127) * 4u;
        f32x4 S[2] = {(f32x4){0.f, 0.f, 0.f, 0.f}, (f32x4){0.f, 0.f, 0.f, 0.f}};
        float tailp = 0.f;
        u32x4 k4A[2], k4B[2], k4C[2], k4D[2]; u32x4 q4A[2], q4B[2], q4C[2], q4D[2]; u32x2 v4A, v4B, v4C, v4D; float rvA, tlA, rvB, tlB, rvC, tlC, rvD, tlD;
#define SCAN_LOAD(n, k4, q4, v4, rv, tl) do { const size_t cb_ = (size_t)scan_cid((n), dir, b) * 65536; const size_t rb_ = (size_t)scan_cid((n), dir, b) * 2048; SB_(); \
            _Pragma("unroll") for (int i = 0; i < 2; ++i) { k4[i] = *(const u32x4*)(Kx + cb_ + (qoff0 + (unsigned)i * qstep)); SB_(); } \
            _Pragma("unroll") for (int i = 0; i < 2; ++i) { q4[i] = *(const u32x4*)(Qx + cb_ + (qoff0 + (unsigned)i * qstep)); SB_(); } \
            v4 = *(const u32x2*)(Vx + cb_ + voff); SB_(); rv = *(const float*)(Rx + rb_ + roff); SB_(); tl = *(const float*)(Tx + rb_ + roff); SB_(); } while (0)
#define SCAN_STAGE(bf, k4, q4, v4, rv, tl) do { LAS unsigned char* B_ = lds + (bf) * BUFB; \
            _Pragma("unroll") for (int i = 0; i < 2; ++i) { const int pc = tid + 512 * i; *(LAS u32x4*)(B_ + ((pc >> 4) * QST + (pc & 15) * 8) * 2) = q4[i]; *(LAS u32x4*)(B_ + OFF_KS + ((pc >> 4) * QST + (pc & 15) * 8) * 2) = k4[i]; } \
            *(LAS u32x2*)(B_ + OFF_V + ((tid >> 3) * VST + (tid & 7) * 4) * 2) = v4; \
            if (tid < 128) { scs[(bf) * 128 + tid] = __expf(rv + tailp); tailp = tl; } } while (0)
#define SCAN_MAT(bf, n) do { LAS unsigned char* B_ = lds + (bf) * BUFB; LAS bf16_t* Qs = (LAS bf16_t*)B_; LAS bf16_t* Ks = (LAS bf16_t*)(B_ + OFF_KS); LAS bf16_t* Vs = (LAS bf16_t*)(B_ + OFF_V); \
            _Pragma("unroll") for (int ti = 0; ti < 2; ++ti) { const int db = 2 * tb + ti; const float scv = scs[(bf) * 128 + 16 * db + ln]; S[ti] *= scv; \
                *(LAS u32x2*)(Sr + (16 * db + ln) * VST + 16 * eb + 4 * lq) = (u32x2){cvt_pk_bf16(S[ti][0], S[ti][1]), cvt_pk_bf16(S[ti][2], S[ti][3])}; } \
            bf16x8 Bq[4]; f32x4 pt[4]; \
            _Pragma("unroll") for (int ks = 0; ks < 4; ++ks) Bq[ks] = *(const LAS bf16x8*)(Qs + (16 * tb + ln) * QST + ks * 32 + lq * 8); \
            _Pragma("unroll") for (int sb = 0; sb < 4; ++sb) { pt[sb] = (f32x4){0.f, 0.f, 0.f, 0.f}; \
                if (sb <= tb) { f32x4 a = (f32x4){0.f, 0.f, 0.f, 0.f}; \
                    _Pragma("unroll") for (int ks = 0; ks < 4; ++ks) { const bf16x8 Ak = *(const LAS bf16x8*)(Ks + (16 * sb + ln) * QST + ks * 32 + lq * 8); a = MFMA16(Ak, Bq[ks], a); } \
                    if (sb == tb) { _Pragma("unroll") for (int i = 0; i < 4; ++i) if (4 * lq + i > ln) a[i] = 0.f; } \
                    pt[sb] = a; } } \
            SCAN_BAR(); \
            f32x4 o = (f32x4){0.f, 0.f, 0.f, 0.f}; \
            _Pragma("unroll") for (int ks = 0; ks < 4; ++ks) { const bf16x8 As = tr_pair(Sr, VST, 32 * ks + 8 * lq, 32 * ks + 8 * lq + 4, 16 * eb, ln); o = MFMA16(As, Bq[ks], o); } \
            _Pragma("unroll") for (int g = 0; g < 2; ++g) { if (2 * g <= tb) { \
                    const bf16x8 Av = tr_pair(Vs, VST, 32 * g + 4 * lq, 32 * g + 16 + 4 * lq, 16 * eb, ln); \
                    const u32x4 bp = {cvt_pk_bf16_mfma(pt[2 * g][0], pt[2 * g][1]), cvt_pk_bf16(pt[2 * g][2], pt[2 * g][3]), cvt_pk_bf16(pt[2 * g + 1][0], pt[2 * g + 1][1]), cvt_pk_bf16(pt[2 * g + 1][2], pt[2 * g + 1][3])}; \
                    o = MFMA16(Av, __builtin_bit_cast(bf16x8, bp), o); } } \
            { const int pos = 16 * tb + ln; const size_t row = (size_t)scan_cid((n), dir, b) * 64 + (dir ? 63 - pos : pos); \
              bf16_t* dst = ((n) >= 4) ? O + ((size_t)dir * NLAT + row) * 512 + h * 128 + es * 32 : Odummy + (size_t)pos * 512;     \
              *(u32x2*)(dst + 16 * eb + 4 * lq) = (u32x2){cvt_pk_bf16_mfma(o[0], o[1]), cvt_pk_bf16_mfma(o[2], o[3])}; } \
            _Pragma("unroll") for (int k2i = 0; k2i < 2; ++k2i) { const bf16x8 Av = tr_pair(Vs, VST, 32 * k2i + 8 * lq, 32 * k2i + 8 * lq + 4, 16 * eb, ln); \
                _Pragma("unroll") for (int ti = 0; ti < 2; ++ti) { const bf16x8 Bk = tr_pair(Ks, QST, 32 * k2i + 8 * lq, 32 * k2i + 8 * lq + 4, 16 * (2 * tb + ti), ln); S[ti] = MFMA16(Av, Bk, S[ti]); } } \
            } while (0)
        SCAN_LOAD(0, k4A, q4A, v4A, rvA, tlA); SCAN_LOAD(1, k4B, q4B, v4B, rvB, tlB); SCAN_LOAD(2, k4C, q4C, v4C, rvC, tlC); SCAN_LOAD(3, k4D, q4D, v4D, rvD, tlD);
        SCAN_STAGE(0, k4A, q4A, v4A, rvA, tlA); SCAN_LOAD(4, k4A, q4A, v4A, rvA, tlA);
        SCAN_BAR();
#pragma unroll 1
        for (int n0 = 0; n0 < 68; n0 += 4) {
            SCAN_STAGE(1, k4B, q4B, v4B, rvB, tlB); SCAN_LOAD(min(n0 + 5, 67), k4B, q4B, v4B, rvB, tlB); SCAN_MAT(0, n0); SCAN_BAR();
            SCAN_STAGE(0, k4C, q4C, v4C, rvC, tlC); SCAN_LOAD(min(n0 + 6, 67), k4C, q4C, v4C, rvC, tlC); SCAN_MAT(1, n0 + 1); SCAN_BAR();
            SCAN_STAGE(1, k4D, q4D, v4D, rvD, tlD); SCAN_LOAD(min(n0 + 7, 67), k4D, q4D, v4D, rvD, tlD); SCAN_MAT(0, n0 + 2); SCAN_BAR();
            SCAN_STAGE(0, k4A, q4A, v4A, rvA, tlA); SCAN_LOAD(min(n0 + 8, 67), k4A, q4A, v4A, rvA, tlA); SCAN_MAT(1, n0 + 3); SCAN_BAR();
        }
#undef SCAN_LOAD
#undef SCAN_STAGE
#undef SCAN_MAT
    }
}

__device__ void conv_phase(LAS unsigned char* lds, const Params& p) {
    const int tid = threadIdx.x, w = tid >> 6, lane = tid & 63;
    LAS float* wl = (LAS float*)lds;
    for (int i = tid; i < 32 * 128; i += NTHR) ((LAS f32x4*)wl)[i] = (i < 31 * 128) ? ((const f32x4*)p.conv_w)[i] : (f32x4){0.f, 0.f, 0.f, 0.f};
    __syncthreads();
    const bf16_t* Gp = (const bf16_t*)(p.ws + WS_G); const bf16_t* GAp = (const bf16_t*)(p.ws + WS_GA); const bf16_t* GBp = (const bf16_t*)(p.ws + WS_GB);
    const bf16_t* O = (const bf16_t*)p.out;
    bf16_t* A2 = (bf16_t*)(p.ws + WS_A);
    const int half = lane >> 5, ch0 = lane * 8;
    for (int it = blockIdx.x * 8 + w; it < 8192; it += gridDim.x * 8) {
        const int b = it >> 10, r0 = ((it >> 5) & 31) * 2, c0 = (it & 31) * 2;
        float acc[4][8];
        const char* Pb = (const char*)Gp;
        const int base = half ? r0 : c0;
        const unsigned stepB = (half ? 64u : 1u) * 1024u;
#pragma unroll 1
        for (int line = 0; line < 2; ++line) {
            const int tok0 = half ? (c0 + line) : (r0 + line) * 64;
            const unsigned offb = (unsigned)((b * 4096 + tok0) * 512 + ch0) * 2u;
            asm volatile("" ::: "memory");
            float cur[2][8];
#pragma unroll
            for (int a = 0; a < 2; ++a)
#pragma unroll
                for (int c = 0; c < 8; ++c) cur[a][c] = 0.f;
            float Wp[8];
#pragma unroll
            for (int c = 0; c < 8; ++c) Wp[c] = 0.f;
#pragma unroll 1
            for (int hb = 0; hb < 4; ++hb) {
                u32x4 raw[8];
#pragma unroll
                for (int q = 0; q < 8; ++q) {
                    const int xx = base - 15 + hb * 8 + q;
                    const int xc = min(max(xx, 0), 63);
                    const u32x4 r = *(const u32x4*)(Pb + (offb + (unsigned)xc * stepB));
                    const bool ok = (xx == xc);
                    raw[q] = (u32x4){ok ? r[0] : 0u, ok ? r[1] : 0u, ok ? r[2] : 0u, ok ? r[3] : 0u};
                }
                const LAS float* wrow = wl + hb * 8 * 512 + ch0;
#pragma unroll
                for (int q = 0; q < 8; ++q) {
                    const float in[8] = {bf_lo(raw[q][0]), bf_hi(raw[q][0]), bf_lo(raw[q][1]), bf_hi(raw[q][1]), bf_lo(raw[q][2]), bf_hi(raw[q][2]), bf_lo(raw[q][3]), bf_hi(raw[q][3])};
                    const f32x4 wa = *(const LAS f32x4*)(wrow + q * 512), wb = *(const LAS f32x4*)(wrow + q * 512 + 4);
                    const float Wc[8] = {wa[0], wa[1], wa[2], wa[3], wb[0], wb[1], wb[2], wb[3]};
#pragma unroll
                    for (int c = 0; c < 8; ++c) { cur[0][c] += Wc[c] * in[c]; cur[1][c] += Wp[c] * in[c]; Wp[c] = Wc[c]; }
                }
            }
#pragma unroll
            for (int j = 0; j < 2; ++j)
#pragma unroll
                for (int c = 0; c < 8; ++c) { if (line == 0) acc[j][c] = cur[j][c]; else acc[2 + j][c] = cur[j][c]; }
        }
        float cbv[8], lg[8], lbv[8], hg[8];
        { const f32x4 a0 = *(const f32x4*)(p.conv_b + ch0), a1 = *(const f32x4*)(p.conv_b + ch0 + 4), b0 = *(const f32x4*)(p.conv_ln_g + ch0), b1 = *(const f32x4*)(p.conv_ln_g + ch0 + 4);
          const f32x4 d0 = *(const f32x4*)(p.conv_ln_b + ch0), d1 = *(const f32x4*)(p.conv_ln_b + ch0 + 4), e0 = *(const f32x4*)(p.hgrn_norm_g + ch0), e1 = *(const f32x4*)(p.hgrn_norm_g + ch0 + 4);
#pragma unroll
          for (int c = 0; c < 4; ++c) { cbv[c] = a0[c]; cbv[4 + c] = a1[c]; lg[c] = b0[c]; lg[4 + c] = b1[c]; lbv[c] = d0[c]; lbv[4 + c] = d1[c]; hg[c] = e0[c]; hg[4 + c] = e1[c]; } }
#pragma unroll
        for (int lr = 0; lr < 2; ++lr)
#pragma unroll
            for (int lc = 0; lc < 2; ++lc) {
                const size_t token = (size_t)b * 4096 + (r0 + lr) * 64 + (c0 + lc);
                float v[8]; float s1 = 0.f, s2 = 0.f;
#pragma unroll
                for (int c = 0; c < 8; ++c) { v[c] = (half ? acc[lc * 2 + lr][c] : acc[lr * 2 + lc][c]) + cbv[c]; s1 += v[c]; s2 += v[c] * v[c]; }
#pragma unroll
                for (int m = 32; m >= 1; m >>= 1) { s1 += __shfl_xor(s1, m); s2 += __shfl_xor(s2, m); }
                const float mean = s1 * (1.f / 512.f), var = fmaxf(s2 * (1.f / 512.f) - mean * mean, 0.f), rstd = rsqrtf(var + EPS);
                const u32x4 gbr = *(const u32x4*)(GBp + token * 512 + ch0);
                const float gbv[8] = {bf_lo(gbr[0]), bf_hi(gbr[0]), bf_lo(gbr[1]), bf_hi(gbr[1]), bf_lo(gbr[2]), bf_hi(gbr[2]), bf_lo(gbr[3]), bf_hi(gbr[3])};
                float y[8];
#pragma unroll
                for (int c = 0; c < 8; ++c) { const float t = (v[c] - mean) * rstd * lg[c] + lbv[c]; y[c] = siluf_(t) * gbv[c]; }
                u32x4 ob = {cvt_pk_bf16(y[0], y[1]), cvt_pk_bf16(y[2], y[3]), cvt_pk_bf16(y[4], y[5]), cvt_pk_bf16(y[6], y[7])};
                *(u32x4*)(A2 + token * 1024 + 512 + ch0) = ob;
                const u32x4 fo = *(const u32x4*)(O + token * 512 + ch0), bo = *(const u32x4*)(O + ((size_t)NLAT + token) * 512 + ch0);
                float ov[8]; float ss = 0.f;
#pragma unroll
                for (int c = 0; c < 4; ++c) { ov[2 * c] = bf_lo(fo[c]) + bf_lo(bo[c]); ov[2 * c + 1] = bf_hi(fo[c]) + bf_hi(bo[c]); }
#pragma unroll
                for (int c = 0; c < 8; ++c) ss += ov[c] * ov[c];
                ss += __shfl_xor(ss, 1); ss += __shfl_xor(ss, 2); ss += __shfl_xor(ss, 4); ss += __shfl_xor(ss, 8);
                const float rn = rsqrtf(ss * (1.f / 128.f) + EPS);
                const u32x4 gar = *(const u32x4*)(GAp + token * 512 + ch0);
                const float gav[8] = {bf_lo(gar[0]), bf_hi(gar[0]), bf_lo(gar[1]), bf_hi(gar[1]), bf_lo(gar[2]), bf_hi(gar[2]), bf_lo(gar[3]), bf_hi(gar[3])};
                float z[8];
#pragma unroll
                for (int c = 0; c < 8; ++c) z[c] = ov[c] * rn * hg[c] * gav[c];
                u32x4 oa = {cvt_pk_bf16(z[0], z[1]), cvt_pk_bf16(z[2], z[3]), cvt_pk_bf16(z[4], z[5]), cvt_pk_bf16(z[6], z[7])};
                *(u32x4*)(A2 + token * 1024 + ch0) = oa;
            }
    }
}

__device__ void final_phase(const Params& p) {
    const int tid = threadIdx.x, w = tid >> 6, lane = tid & 63;
    const float* modp = (const float*)(p.ws + WS_MODP);
    const bf16_t* Y = (const bf16_t*)(p.ws + WS_QF);
    const int rows_per = NLAT / gridDim.x;
    for (int r0 = blockIdx.x * rows_per; r0 < NLAT; r0 += gridDim.x * rows_per) {
        const int rend = min(r0 + rows_per, NLAT);
        int curb = -1; f32x4 gt[4], g[4];
#pragma unroll
        for (int c = 0; c < 4; ++c) { g[c] = *(const f32x4*)(p.final_norm_g + c * 256 + lane * 4); gt[c] = (f32x4){0.f, 0.f, 0.f, 0.f}; }
        for (int row = r0 + w * 2; row < rend; row += 16) {
            const int b = row >> 12;
            if (b != curb) { curb = b;
#pragma unroll
                for (int c = 0; c < 4; ++c) { f32x4 t = *(const f32x4*)(p.b_mod + 2048 + c * 256 + lane * 4);
#pragma unroll
                    for (int q = 0; q < 4; ++q) t += *(const f32x4*)(modp + (q * 9 + b) * 3072 + 2048 + c * 256 + lane * 4);
                    gt[c] = t; } }
            const float* xp = p.x + (size_t)row * 1024; const bf16_t* yp = Y + (size_t)row * 1024; float* op = p.out + (size_t)row * 1024;
            f32x4 h0[4], h1[4]; float s0 = 0.f, s1 = 0.f;
#pragma unroll
            for (int c = 0; c < 4; ++c) {
                const f32x4 x0 = *(const f32x4*)(xp + c * 256 + lane * 4), x1 = *(const f32x4*)(xp + 1024 + c * 256 + lane * 4);
                const u32x2 y0 = *(const u32x2*)(yp + c * 256 + lane * 4), y1 = *(const u32x2*)(yp + 1024 + c * 256 + lane * 4);
                h0[c] = x0 + gt[c] * (f32x4){bf_lo(y0[0]), bf_hi(y0[0]), bf_lo(y0[1]), bf_hi(y0[1])};
                h1[c] = x1 + gt[c] * (f32x4){bf_lo(y1[0]), bf_hi(y1[0]), bf_lo(y1[1]), bf_hi(y1[1])};
                s0 += h0[c][0] * h0[c][0] + h0[c][1] * h0[c][1] + h0[c][2] * h0[c][2] + h0[c][3] * h0[c][3];
                s1 += h1[c][0] * h1[c][0] + h1[c][1] * h1[c][1] + h1[c][2] * h1[c][2] + h1[c][3] * h1[c][3];
            }
#pragma unroll
            for (int m = 32; m >= 1; m >>= 1) { s0 += __shfl_xor(s0, m); s1 += __shfl_xor(s1, m); }
            const float rs0 = rsqrtf(s0 * (1.f / 1024.f) + EPS), rs1 = rsqrtf(s1 * (1.f / 1024.f) + EPS);
#pragma unroll
            for (int c = 0; c < 4; ++c) { *(f32x4*)(op + c * 256 + lane * 4) = h0[c] * rs0 * g[c]; *(f32x4*)(op + 1024 + c * 256 + lane * 4) = h1[c] * rs1 * g[c]; }
        }
    }
}

__global__ void __launch_bounds__(NTHR, 2) hymba_fwd(Params p) {
    extern __shared__ __attribute__((aligned(16))) unsigned char lds_raw[];
    LAS unsigned char* lds = (LAS unsigned char*)lds_raw;
    const int lo = p.ph_lo, hi = p.ph_hi;
#define IN(k) (lo <= (k) && (k) < hi)
#if N_LAUNCHES == 1
    volatile LAS unsigned* bst = (volatile LAS unsigned*)(lds + 131072);
    if (threadIdx.x < 4) bst[threadIdx.x] = 0u;
    __syncthreads();
    const XcdBarrier bar = xcd_barrier_post((unsigned*)(p.ws + WS_BAR), bst);
#define SEAM(k) do { if (IN(k) && IN((k) + 1)) xcd_barrier(bar); } while (0)
#else
#define SEAM(k) do { } while (0)
#endif
#ifndef DUP_PHASE
#define DUP_PHASE -1
#endif
    if (IN(0)) phase0(lds, p, 0, 192 + 1280);
    SEAM(0);
    if (IN(1)) phase1(lds, p);
    SEAM(1);
    if (IN(2)) {
        pg8::Gemm g{(const bf16_t*)(p.ws + WS_A), (const bf16_t*)(p.ws + WS_WIN), NROWS, 4096, 1024};
        pg8::InOrder S; S.init(NLAT, 4096, gridDim.x, blockIdx.x);
        EpiIn E{p.ws, p.lb_logits};
#pragma unroll 1
        for (int rep = 0; rep < (DUP_PHASE == 2 ? 2 : 1); ++rep) pg8::gemm_phase<EpiIn, pg8::InOrder>(lds, g, S, E);
    }
    SEAM(2);
    if (IN(3)) {
#pragma unroll 1
        for (int rep = 0; rep < (DUP_PHASE == 3 ? 2 : 1); ++rep) scan_phase(lds, p);
    }
    SEAM(3);
    if (IN(4)) { conv_phase(lds, p); if (DUP_PHASE == 4) { __syncthreads(); conv_phase(lds, p); } }
    SEAM(4);
    if (IN(5)) {
        pg8::Gemm g{(const bf16_t*)(p.ws + WS_A), (const bf16_t*)(p.ws + WS_WOUT), NLAT, 1024, 1024};
        pg8::StaticOrder S; S.init(NLAT, 1024, gridDim.x, blockIdx.x);
        EpiOut E{(bf16_t*)(p.ws + WS_QF)};
#pragma unroll 1
        for (int rep = 0; rep < (DUP_PHASE == 5 ? 2 : 1); ++rep) pg8::gemm_phase<EpiOut, pg8::StaticOrder>(lds, g, S, E);
    }
    SEAM(5);
    if (IN(6)) final_phase(p);
}

extern "C" void kernel_launch(void* const* d_in, const int* in_sizes, int n_in, void* d_out, int out_size, void* d_ws, size_t ws_size, hipStream_t stream) {
    static int grid = 0;
    if (grid == 0) {
        int dev = 0, cus = 0, per_cu = 0;
        hipGetDevice(&dev);
        hipDeviceGetAttribute(&cus, hipDeviceAttributeMultiprocessorCount, dev);
        hipFuncSetAttribute((const void*)hymba_fwd, hipFuncAttributeMaxDynamicSharedMemorySize, LDS_BYTES);
        hipOccupancyMaxActiveBlocksPerMultiprocessor(&per_cu, (const void*)hymba_fwd, NTHR, LDS_BYTES);
        if (per_cu < 1) { fprintf(stderr, "kernel_launch: occupancy query says %d blocks/CU\n", per_cu); per_cu = 1; }
        grid = cus * per_cu;
        if (ws_size < WS_END) { fprintf(stderr, "kernel_launch: workspace too small (%zu < %zu)\n", ws_size, (size_t)WS_END); grid = -1; }
    }
    if (grid < 0) return;
    Params p{};
    p.x = (const float*)d_in[0]; p.c = (const float*)d_in[1]; p.ctx = (const float*)d_in[2]; p.c_ctx = (const float*)d_in[3]; p.norm_g = (const float*)d_in[4];
    p.w_mod = (const float*)d_in[5]; p.b_mod = (const float*)d_in[6]; p.w_in = (const float*)d_in[7]; p.lb_logits = (const float*)d_in[8]; p.hgrn_norm_g = (const float*)d_in[9];
    p.conv_w = (const float*)d_in[10]; p.conv_b = (const float*)d_in[11]; p.conv_ln_g = (const float*)d_in[12]; p.conv_ln_b = (const float*)d_in[13]; p.w_out = (const float*)d_in[14];
    p.final_norm_g = (const float*)d_in[15];
    p.out = (float*)d_out; p.ws = (unsigned char*)d_ws;
#if N_LAUNCHES == 1
    p.ph_lo = 0; p.ph_hi = 7;
    hipMemsetAsync((unsigned char*)d_ws + WS_BAR, 0, XCD_BAR_WORDS * 4, stream);
    void* args[] = {&p};
    hipError_t e = hipLaunchCooperativeKernel((const void*)hymba_fwd, dim3(grid), dim3(NTHR), args, LDS_BYTES, stream);
    if (e != hipSuccess) fprintf(stderr, "cooperative launch failed: %s (grid %d)\n", hipGetErrorString(e), grid);
#else
    for (int ph = 0; ph < 7; ++ph) { p.ph_lo = ph; p.ph_hi = ph + 1; hipLaunchKernelGGL(hymba_fwd, dim3(grid), dim3(NTHR), LDS_BYTES, stream, p); }
#endif
}
```

```cpp
#include <hip/hip_runtime.h>
#include <hip/hip_cooperative_groups.h>
#include <cstdio>
namespace cg = cooperative_groups;

#ifndef N_LAUNCHES
#define N_LAUNCHES 1
#endif

#define LAS __attribute__((address_space(3)))
typedef unsigned short bf16_t;
typedef short bf16x8 __attribute__((ext_vector_type(8)));
typedef float f32x4 __attribute__((ext_vector_type(4)));
typedef float f32x2 __attribute__((ext_vector_type(2)));
typedef unsigned u32x4 __attribute__((ext_vector_type(4)));
typedef unsigned u32x2 __attribute__((ext_vector_type(2)));

constexpr int NTHR = 512;
constexpr int DM = 1024, NLAT = 32768, NROWS = 34816;
constexpr int NCHUNK = NROWS / 64;
constexpr float EPS = 1e-6f;
constexpr int LDS_BYTES = 131072 + 16;

constexpr size_t WS_WIN = 0;
constexpr size_t WS_WOUT = 8388608;
constexpr size_t WS_MODP = 10485760;
constexpr size_t WS_RSS = 11010048;
constexpr size_t WS_BAR = 13107200;
constexpr size_t WS_A = 13631488;
constexpr size_t SZ_S = (size_t)NROWS * 512 * 2, SZ_L = (size_t)NLAT * 512 * 2;
constexpr size_t WS_QF = WS_A + (size_t)NROWS * 1024 * 2;
constexpr size_t WS_QB = WS_QF + SZ_S;
constexpr size_t WS_KF = WS_QB + SZ_S;
constexpr size_t WS_KB = WS_KF + SZ_S;
constexpr size_t WS_V = WS_KB + SZ_S;
constexpr size_t WS_GA = WS_V + SZ_S;
constexpr size_t WS_G = WS_GA + SZ_L;
constexpr size_t WS_GB = WS_G + SZ_L;
constexpr size_t WS_RT = WS_GB + SZ_L;
constexpr size_t WS_END = WS_RT + (size_t)2 * 2 * NCHUNK * 512 * 4;

struct Params {
    const float *x, *c, *ctx, *c_ctx, *norm_g, *w_mod, *b_mod, *w_in, *lb_logits, *hgrn_norm_g, *conv_w, *conv_b, *conv_ln_g, *conv_ln_b, *w_out, *final_norm_g;
    float* out; unsigned char* ws; int ph_lo, ph_hi;
};

__device__ __forceinline__ unsigned cvt_pk_bf16(float lo, float hi) { unsigned r; asm volatile("v_cvt_pk_bf16_f32 %0, %1, %2" : "=v"(r) : "v"(lo), "v"(hi)); return r; }
__device__ __forceinline__ unsigned cvt_pk_bf16_mfma(float lo, float hi) { unsigned r; asm volatile("s_nop 15\n\ts_nop 7\n\tv_cvt_pk_bf16_f32 %0, %1, %2" : "=v"(r) : "v"(lo), "v"(hi)); return r; }
__device__ __forceinline__ float bf_lo(unsigned u) { return __uint_as_float(u << 16); }
__device__ __forceinline__ float bf_hi(unsigned u) { return __uint_as_float(u & 0xffff0000u); }
__device__ __forceinline__ float sigmoidf_(float v) { return __builtin_amdgcn_rcpf(1.f + __expf(-v)); }
__device__ __forceinline__ float siluf_(float v) { return v * __builtin_amdgcn_rcpf(1.f + __expf(-v)); }


#define XB_TMO      128
#define XB_XCNT(j)  (256  + 64 * (j))
#define XB_XSUB(j)  (1280 + 64 * (j))
#define XB_XGEN(j)  (2304 + 64 * (j))
#define XB_TOP      3328
#define XB_TOPGEN   3392
#define XCD_BAR_WORDS 3456
#define XB_SPIN_CAP (1u << 18)
__device__ __forceinline__ unsigned xb_ld(unsigned* p)              { return __hip_atomic_load(p, __ATOMIC_RELAXED, __HIP_MEMORY_SCOPE_AGENT); }
__device__ __forceinline__ unsigned xb_add(unsigned* p, unsigned v) { return __hip_atomic_fetch_add(p, v, __ATOMIC_RELAXED, __HIP_MEMORY_SCOPE_AGENT); }
__device__ __forceinline__ unsigned xb_xcc_id() { return (unsigned)__builtin_amdgcn_s_getreg((3 << 11) | 20) & 0xFu; }
#define XB_SPIN(cond, bar) do { unsigned _sp = 0; while (cond) { __builtin_amdgcn_s_sleep(1); \
    if ((++_sp & 255u) == 0u) { if (xb_ld(&(bar)[XB_TMO])) break; if (_sp > XB_SPIN_CAP) { atomicAdd(&(bar)[XB_TMO], 1u); break; } } } } while (0)
struct XcdBarrier { unsigned* bar; unsigned x; volatile LAS unsigned* st; };
__device__ __forceinline__ XcdBarrier xcd_barrier_post(unsigned* bar, volatile LAS unsigned* st) {
    XcdBarrier b; b.bar = bar; b.x = xb_xcc_id(); b.st = st;
    if (threadIdx.x == 0) (void)xb_add(&bar[XB_XCNT(b.x)], 1u);
    return b;
}
__device__ __forceinline__ void xcd_barrier_complete(unsigned* bar, unsigned x, unsigned& nloc, unsigned& nx) {
    const unsigned G = gridDim.x * gridDim.y * gridDim.z;
    unsigned sum, cnt, mine, sp = 0u;
    for (;;) {
        sum = 0u; cnt = 0u; mine = 0u;
#pragma unroll
        for (unsigned j = 0; j < 16; ++j) { const unsigned c = xb_ld(&bar[XB_XCNT(j)]); sum += c; cnt += (c > 0u) ? 1u : 0u; mine = (j == x) ? c : mine; }
        if (sum == G) break;
        __builtin_amdgcn_s_sleep(1);
        if ((++sp & 255u) == 0u) { if (xb_ld(&bar[XB_TMO])) break; if (sp > XB_SPIN_CAP) { atomicAdd(&bar[XB_TMO], 1u); break; } }
    }
    nloc = mine > 0u ? mine : 1u; nx = cnt > 0u ? cnt : 1u;
}
__device__ __forceinline__ void xcd_barrier(const XcdBarrier& b) {
    asm volatile("s_waitcnt vmcnt(0)" ::: "memory");
    __syncthreads();
    if (threadIdx.x == 0) {
        unsigned* bar = b.bar;
        __builtin_amdgcn_s_waitcnt(0);
        unsigned nloc = b.st[0], nx = b.st[1];
        if (nloc == 0u) { xcd_barrier_complete(bar, b.x, nloc, nx); b.st[0] = nloc; b.st[1] = nx; }
        const unsigned old = xb_add(&bar[XB_XSUB(b.x)], 1u);
        const unsigned gen = old / nloc;
        if (old + 1u == (gen + 1u) * nloc) {
            __builtin_amdgcn_fence(__ATOMIC_RELEASE, "agent");
            asm volatile("s_waitcnt vmcnt(0)" ::: "memory");
            const unsigned og = xb_add(&bar[XB_TOP], 1u);
            const unsigned tg = og / nx;
            if (og + 1u == (tg + 1u) * nx) xb_add(&bar[XB_TOPGEN], 1u);
            else XB_SPIN(xb_ld(&bar[XB_TOPGEN]) == tg, bar);
            __builtin_amdgcn_fence(__ATOMIC_ACQUIRE, "agent");
            xb_add(&bar[XB_XGEN(b.x)], 1u);
            asm volatile("s_waitcnt vmcnt(0)" ::: "memory");
        } else {
            XB_SPIN(xb_ld(&bar[XB_XGEN(b.x)]) == gen, bar);
            __builtin_amdgcn_fence(__ATOMIC_ACQUIRE, "agent");
            asm volatile("s_waitcnt vmcnt(0)" ::: "memory");
        }
    }
    __syncthreads();
}

namespace pg8 {
constexpr int BM = 256, BK = 64, HALF = 128, HTB = HALF * BK * 2, STAGE_BYTES = 8 * HTB, NXCD = 8, WGM = 8;
__host__ __device__ __forceinline__ int lds_byte(int r, int c) { const int st = (r >> 4) * 2 + (c >> 5), rr = r & 15, cc = c & 31, ob = rr * 64 + cc * 2; return st * 1024 + (ob ^ (((ob >> 9) & 1) << 5)); }
__host__ __device__ __forceinline__ void stage_rc(int b, int& R, int& C) { const int st = b / 1024, sb = b % 1024, swz = sb ^ (((sb >> 9) & 1) << 5); R = (st >> 1) * 16 + swz / 64; C = (st & 1) * 32 + (swz % 64) / 2; }
__host__ __device__ __forceinline__ int perm32(int rho) { const int n = rho >> 4, i = rho & 15; return 8 * (i >> 2) + 4 * n + (i & 3); }
struct Unit { int pm, pn; };
struct Gemm { const bf16_t* A; const bf16_t* Bt; int M, N, K; };
struct StaticOrder {
    int nM, nN, nwg, G, c;
    __device__ void init(int M, int N, int G_, int c_) { nM = M / BM; nN = N / BM; nwg = nM * nN; G = G_; c = c_; }
    __device__ bool map(int L, Unit& u) const {
        int wgid = L; { const int q = nwg / NXCD, r = nwg % NXCD, xcd = wgid % NXCD, off = wgid / NXCD; wgid = (xcd < r ? xcd * (q + 1) : r * (q + 1) + (xcd - r) * q) + off; }
        const int nig = WGM * nN, gid = wgid / nig, fm = gid * WGM, gsz = (nM - fm) < WGM ? (nM - fm) : WGM;
        u.pm = fm + ((wgid % nig) % gsz); u.pn = (wgid % nig) / gsz; return true;
    }
    __device__ bool next(int i, Unit& u) const { const long L = (long)i * G + c; if (L >= nwg) return false; return map((int)L, u); }
};
struct InOrder : StaticOrder {
    __device__ bool next(int i, Unit& u) const {
        const long L = (long)i * G + c;
        if (L < nwg) return map((int)L, u);
        const int k = (int)(L - nwg); if (k >= 64) return false;
        u.pm = 128 + (k >> 3); u.pn = k & 7; return true;
    }
};

template <class Epi, class Sched>
__device__ __forceinline__ void gemm_phase(LAS unsigned char* lds, const Gemm g, const Sched& S, const Epi& E) {
    const int tid = threadIdx.x, wid = __builtin_amdgcn_readfirstlane(tid >> 6), lane = tid & 63, wr = wid >> 2, wc = wid & 3, fr = lane & 15, fq = lane >> 4;
    const int K = g.K, nt = K / BK;
    unsigned voffA[2], voffB[2];
#pragma unroll
    for (int i = 0; i < 2; ++i) { int R, C; stage_rc(tid * 16 + i * 8192, R, C); const int Rb = Epi::PERM ? ((R & ~31) + perm32(R & 31)) : R;
        voffA[i] = (unsigned)(R * K + C) * 2u; voffB[i] = (unsigned)(Rb * K + C) * 2u; }
    const size_t kstep = (size_t)(BK * 2);
    const size_t hstep = (size_t)HALF * K * 2;
    const size_t tstep = 2 * hstep;
    const unsigned ldsw = (unsigned)wid * 1024u;
    const int aoff = lds_byte(wr * 64 + fr, fq * 8), boff = lds_byte(wc * 32 + fr, fq * 8);
#define PG8_SA(b, h) (((b) * 2 + (h)) * HTB)
#define PG8_SB(b, h) ((4 + (b) * 2 + (h)) * HTB)
#define PG8_STAGE(bufoff, gbase, voff) do { _Pragma("unroll") for (int _i = 0; _i < 2; ++_i) \
        __builtin_amdgcn_global_load_lds((const unsigned*)((const char*)(gbase) + (voff)[_i]), (LAS unsigned*)(lds + (bufoff) + ldsw + _i * 8192), 16, 0, 0); } while (0)
#define PG8_LDA(dst, b, h) do { _Pragma("unroll") for (int m = 0; m < 4; ++m) _Pragma("unroll") for (int k = 0; k < 2; ++k) dst[m][k] = *(const LAS bf16x8*)(lds + PG8_SA(b, h) + aoff + m * 2048 + k * 1024); } while (0)
#define PG8_LDB(dst, b, h) do { _Pragma("unroll") for (int n = 0; n < 2; ++n) _Pragma("unroll") for (int k = 0; k < 2; ++k) dst[n][k] = *(const LAS bf16x8*)(lds + PG8_SB(b, h) + boff + n * 2048 + k * 1024); } while (0)
#define PG8_MMA(ai, bj, At, Bt) do { __builtin_amdgcn_s_setprio(1); _Pragma("unroll") for (int m = 0; m < 4; ++m) _Pragma("unroll") for (int n = 0; n < 2; ++n) _Pragma("unroll") for (int k = 0; k < 2; ++k) \
        acc[ai][bj][m][n] = __builtin_amdgcn_mfma_f32_16x16x32_bf16(Bt[n][k], At[m][k], acc[ai][bj][m][n], 0, 0, 0); __builtin_amdgcn_s_setprio(0); } while (0)
#define PG8_WAIT_V(n) asm volatile("s_waitcnt vmcnt(" #n ")" ::: "memory")
#define PG8_WAIT_L(n) asm volatile("s_waitcnt lgkmcnt(" #n ")" ::: "memory")
#define PG8_BAR __builtin_amdgcn_s_barrier()
#define PG8_SCHED __builtin_amdgcn_sched_barrier(0)
    Unit cur, nxt; int ui = 0;
    if (!S.next(0, cur)) return;
    f32x4 acc[2][2][4][2];
#pragma unroll
    for (int a = 0; a < 2; ++a)
#pragma unroll
        for (int b = 0; b < 2; ++b)
#pragma unroll
            for (int m = 0; m < 4; ++m)
#pragma unroll
                for (int n = 0; n < 2; ++n) acc[a][b][m][n] = (f32x4){0.f, 0.f, 0.f, 0.f};
    bf16x8 At[4][2], B0[2][2], B1[2][2];
    const char* cA = (const char*)g.A + (size_t)cur.pm * tstep; const char* cB = (const char*)g.Bt + (size_t)cur.pn * tstep;
    PG8_STAGE(PG8_SB(0, 0), cB, voffB); PG8_STAGE(PG8_SA(0, 0), cA, voffA); PG8_STAGE(PG8_SB(0, 1), cB + hstep, voffB); PG8_STAGE(PG8_SA(0, 1), cA + hstep, voffA);
    if (wr == 1) PG8_BAR;
    PG8_WAIT_V(4); PG8_BAR;
    PG8_STAGE(PG8_SB(1, 0), cB + kstep, voffB); PG8_STAGE(PG8_SA(1, 0), cA + kstep, voffA); PG8_STAGE(PG8_SB(1, 1), cB + hstep + kstep, voffB);
    PG8_WAIT_V(6); PG8_BAR;
    for (;;) {
        const bool has_next = S.next(ui + 1, nxt);
        const char* nA = has_next ? (const char*)g.A + (size_t)nxt.pm * tstep : cA; const char* nB = has_next ? (const char*)g.Bt + (size_t)nxt.pn * tstep : cB;
        for (int t = 0; t < nt; t += 2) {
            const bool last = (t == nt - 2);
            const char* a1 = cA + (size_t)(t + 1) * kstep;
            const char* a2 = last ? nA : cA + (size_t)(t + 2) * kstep; const char* b2 = last ? nB : cB + (size_t)(t + 2) * kstep;
            const char* a3 = a2 + kstep; const char* b3 = b2 + kstep;
            PG8_LDB(B0, 0, 0); PG8_SCHED; PG8_LDA(At, 0, 0); PG8_STAGE(PG8_SA(1, 1), a1 + hstep, voffA);
            PG8_WAIT_L(8); PG8_BAR; PG8_WAIT_L(0); PG8_MMA(0, 0, At, B0); PG8_BAR; PG8_SCHED;
            PG8_LDB(B1, 0, 1); PG8_STAGE(PG8_SB(0, 0), b2, voffB);
            PG8_BAR; PG8_WAIT_L(0); PG8_MMA(0, 1, At, B1); PG8_BAR;
            PG8_LDA(At, 0, 1); PG8_STAGE(PG8_SA(0, 0), a2, voffA);
            PG8_BAR; PG8_WAIT_L(0); PG8_MMA(1, 0, At, B0); PG8_BAR; PG8_SCHED;
            PG8_STAGE(PG8_SB(0, 1), b2 + hstep, voffB);
            PG8_WAIT_V(6); PG8_BAR; PG8_MMA(1, 1, At, B1); PG8_BAR;
            PG8_LDB(B0, 1, 0); PG8_SCHED; PG8_LDA(At, 1, 0); PG8_STAGE(PG8_SA(0, 1), a2 + hstep, voffA);
            PG8_WAIT_L(8); PG8_BAR; PG8_WAIT_L(0); PG8_MMA(0, 0, At, B0); PG8_BAR; PG8_SCHED;
            PG8_LDB(B1, 1, 1); PG8_STAGE(PG8_SB(1, 0), b3, voffB);
            PG8_BAR; PG8_WAIT_L(0); PG8_MMA(0, 1, At, B1); PG8_BAR;
            PG8_LDA(At, 1, 1); PG8_STAGE(PG8_SA(1, 0), a3, voffA);
            PG8_BAR; PG8_WAIT_L(0); PG8_MMA(1, 0, At, B0); PG8_BAR; PG8_SCHED;
            PG8_STAGE(PG8_SB(1, 1), b3 + hstep, voffB);
            PG8_WAIT_V(6); PG8_BAR; PG8_MMA(1, 1, At, B1); PG8_BAR;
        }
        if (wr == 0) PG8_BAR;
        E(acc, cur, wr, wc, fr, fq);
        if (wr == 1) PG8_BAR;
        if (!has_next) break;
#pragma unroll
        for (int a = 0; a < 2; ++a)
#pragma unroll
            for (int b = 0; b < 2; ++b)
#pragma unroll
                for (int m = 0; m < 4; ++m)
#pragma unroll
                    for (int n = 0; n < 2; ++n) acc[a][b][m][n] = (f32x4){0.f, 0.f, 0.f, 0.f};
        cur = nxt; cA = nA; cB = nB; ++ui;
    }
    PG8_WAIT_V(0);
    if (wr == 0) PG8_BAR;
    PG8_BAR;
#undef PG8_SA
#undef PG8_SB
#undef PG8_STAGE
#undef PG8_LDA
#undef PG8_LDB
#undef PG8_MMA
#undef PG8_WAIT_V
#undef PG8_WAIT_L
#undef PG8_BAR
#undef PG8_SCHED
}
}

template <int K> __device__ __forceinline__ float dpp_shr(float x) { return __int_as_float(__builtin_amdgcn_update_dpp(0, __float_as_int(x), 0x110 + K, 0xf, 0xf, true)); }
__device__ __forceinline__ float scan16(float x) { x += dpp_shr<1>(x); x += dpp_shr<2>(x); x += dpp_shr<4>(x); x += dpp_shr<8>(x); return x; }
__device__ __forceinline__ float clamp80(float x) { return fminf(fmaxf(x, -80.f), 80.f); }
struct EpiIn {
    static constexpr bool PERM = true;
    unsigned char* ws; const float* lb_logits;
    __device__ __forceinline__ void operator()(const f32x4 (&acc)[2][2][4][2], const pg8::Unit& u, int wr, int wc, int fr, int fq) const {
        asm volatile("s_nop 15\n\ts_nop 15\n\ts_nop 15\n\ts_nop 15" ::: "memory");
        const int row0 = u.pm * 256 + wr * 64 + fr, pn = u.pn;
        if (pn < 8) {
            bf16_t* QF = (bf16_t*)(ws + WS_QF); bf16_t* QB = (bf16_t*)(ws + WS_QB); bf16_t* KF = (bf16_t*)(ws + WS_KF); bf16_t* KB = (bf16_t*)(ws + WS_KB); bf16_t* V = (bf16_t*)(ws + WS_V);
            float* RT = (float*)(ws + WS_RT);
            const int ch0 = 64 * pn + 16 * wc + 4 * fq;
            float lbF[4], lbB[4];
#pragma unroll
            for (int j = 0; j < 4; ++j) { lbF[j] = 1.f / (1.f + __expf(lb_logits[1024 + ch0 + j] - lb_logits[ch0 + j])); lbB[j] = 1.f / (1.f + __expf(lb_logits[1536 + ch0 + j] - lb_logits[512 + ch0 + j])); }
#pragma unroll
            for (int ai = 0; ai < 2; ++ai) {
                const int rowc = u.pm * 256 + 128 * ai + 64 * wr;
                const int cid = rowc >> 6;
                unsigned oQF[4][2], oQB[4][2], oKF[4][2], oKB[4][2]; f32x4 rtv[4];
#pragma unroll
                for (int jp = 0; jp < 2; ++jp) {
                    float vQF[4][2], vQB[4][2], vKF[4][2], vKB[4][2];
#pragma unroll
                    for (int jj = 0; jj < 2; ++jj) {
                        const int j = 2 * jp + jj;
                        float lfF[4], kkF[4], lfB[4], kkB[4], pF[4], pB[4], tF[4], tB[4];
#pragma unroll
                        for (int m = 0; m < 4; ++m) {
                            { const float z = acc[ai][0][m][1][j]; const float e = __expf(fminf(-z, 30.f)); const float s = __builtin_amdgcn_rcpf(1.f + e); lfF[m] = __logf(lbF[j] + (1.f - lbF[j]) * s); kkF[m] = (1.f - lbF[j]) * e * s; }
                            { const float z = acc[ai][1][m][0][j]; const float e = __expf(fminf(-z, 30.f)); const float s = __builtin_amdgcn_rcpf(1.f + e); lfB[m] = __logf(lbB[j] + (1.f - lbB[j]) * s); kkB[m] = (1.f - lbB[j]) * e * s; }
                            pF[m] = scan16(lfF[m]); pB[m] = scan16(lfB[m]);
                            tF[m] = __int_as_float(__builtin_amdgcn_update_dpp(0, __float_as_int(pF[m]), 0x15F, 0xf, 0xf, true));
                            tB[m] = __int_as_float(__builtin_amdgcn_update_dpp(0, __float_as_int(pB[m]), 0x15F, 0xf, 0xf, true));
                        }
                        const float rF = tF[0] + tF[1], blF = rF + tF[2] + tF[3];
                        const float rB = tB[2] + tB[3], blB = rB + tB[0] + tB[1];
                        float cF = 0.f, cB = 0.f;
#pragma unroll
                        for (int m = 0; m < 4; ++m) {
                            const float bF = pF[m] + cF; cF += tF[m];
                            const float bB = blB - (pB[m] + cB) + lfB[m]; cB += tB[m];
                            const float xF = clamp80(bF - rF), xB = clamp80(bB - rB);
                            const float q = acc[ai][0][m][0][j];
                            vQF[m][jj] = q * __expf(xF); vKF[m][jj] = kkF[m] * __expf(-xF);
                            vQB[m][jj] = q * __expf(xB); vKB[m][jj] = kkB[m] * __expf(-xB);
                        }
                        rtv[0][j] = rF; rtv[1][j] = rB; rtv[2][j] = blF - rF; rtv[3][j] = blB - rB;
                    }
#pragma unroll
                    for (int m = 0; m < 4; ++m) { oQF[m][jp] = cvt_pk_bf16(vQF[m][0], vQF[m][1]); oQB[m][jp] = cvt_pk_bf16(vQB[m][0], vQB[m][1]); oKF[m][jp] = cvt_pk_bf16(vKF[m][0], vKF[m][1]); oKB[m][jp] = cvt_pk_bf16(vKB[m][0], vKB[m][1]); }
                }
                if (fr == 0) {
#pragma unroll
                    for (int t = 0; t < 4; ++t) *(f32x4*)(RT + (size_t)t * NCHUNK * 512 + (size_t)cid * 512 + ch0) = rtv[t];
                }
#pragma unroll
                for (int mp = 0; mp < 2; ++mp) {
                    const int a = 2 * mp, bb = 2 * mp + 1, odd = fq & 1;
                    const size_t off = (size_t)(rowc + 16 * (odd ? bb : a) + fr) * 512 + (ch0 - 4 * odd);
                    const f32x4 va = acc[ai][1][a][1], vb = acc[ai][1][bb][1];
                    const unsigned oVa0 = cvt_pk_bf16(va[0], va[1]), oVa1 = cvt_pk_bf16(va[2], va[3]), oVb0 = cvt_pk_bf16(vb[0], vb[1]), oVb1 = cvt_pk_bf16(vb[2], vb[3]);
                    asm volatile("s_nop 1" ::: "memory");
#define WIDE_ST(P, x0a, x1a, x0b, x1b) do { const u32x2 s0 = __builtin_amdgcn_permlane16_swap((x0a), (x0b), false, false), s1 = __builtin_amdgcn_permlane16_swap((x1a), (x1b), false, false); \
                        *(u32x4*)((P) + off) = (u32x4){s0[0], s1[0], s0[1], s1[1]}; } while (0)
                    WIDE_ST(QF, oQF[a][0], oQF[a][1], oQF[bb][0], oQF[bb][1]); WIDE_ST(QB, oQB[a][0], oQB[a][1], oQB[bb][0], oQB[bb][1]);
                    WIDE_ST(KF, oKF[a][0], oKF[a][1], oKF[bb][0], oKF[bb][1]); WIDE_ST(KB, oKB[a][0], oKB[a][1], oKB[bb][0], oKB[bb][1]);
                    WIDE_ST(V, oVa0, oVa1, oVb0, oVb1);
#undef WIDE_ST
                }
            }
        } else if (pn >= 10 && pn <= 13) {
            bf16_t* G = (bf16_t*)(ws + WS_G);
            const int chb = 128 * (pn - 10) + 16 * wc + 4 * fq;
            const int odd = fq & 1;
#pragma unroll
            for (int ai = 0; ai < 2; ++ai)
#pragma unroll
                for (int mp = 0; mp < 2; ++mp) {
                    const size_t row = (size_t)(row0 + ai * 128 + (2 * mp + odd) * 16);
#pragma unroll
                    for (int bj = 0; bj < 2; ++bj) {
                        const f32x4 ua = acc[ai][bj][2 * mp][0], ga = acc[ai][bj][2 * mp][1], ub = acc[ai][bj][2 * mp + 1][0], gb = acc[ai][bj][2 * mp + 1][1];
                        const unsigned a0 = cvt_pk_bf16(ua[0] * sigmoidf_(ga[0]), ua[1] * sigmoidf_(ga[1])), a1 = cvt_pk_bf16(ua[2] * sigmoidf_(ga[2]), ua[3] * sigmoidf_(ga[3]));
                        const unsigned b0 = cvt_pk_bf16(ub[0] * sigmoidf_(gb[0]), ub[1] * sigmoidf_(gb[1])), b1 = cvt_pk_bf16(ub[2] * sigmoidf_(gb[2]), ub[3] * sigmoidf_(gb[3]));
                        asm volatile("s_nop 1" ::: "memory");
                        const u32x2 s0 = __builtin_amdgcn_permlane16_swap(a0, b0, false, false), s1 = __builtin_amdgcn_permlane16_swap(a1, b1, false, false);
                        *(u32x4*)(G + row * 512 + (chb - 4 * odd) + 64 * bj) = (u32x4){s0[0], s1[0], s0[1], s1[1]};
                    }
                }
        } else {
            bf16_t* D = (bf16_t*)(ws + (pn < 10 ? WS_GA : WS_GB));
            const int colb = 256 * (pn < 10 ? pn - 8 : pn - 14) + 32 * wc + 8 * fq;
#pragma unroll
            for (int ai = 0; ai < 2; ++ai)
#pragma unroll
                for (int m = 0; m < 4; ++m) {
                    const size_t row = (size_t)(row0 + ai * 128 + m * 16);
#pragma unroll
                    for (int bj = 0; bj < 2; ++bj) {
                        f32x4 v0 = acc[ai][bj][m][0], v1 = acc[ai][bj][m][1];
#pragma unroll
                        for (int j = 0; j < 4; ++j) { v0[j] = siluf_(v0[j]); v1[j] = siluf_(v1[j]); }
                        u32x4 o = {cvt_pk_bf16(v0[0], v0[1]), cvt_pk_bf16(v0[2], v0[3]), cvt_pk_bf16(v1[0], v1[1]), cvt_pk_bf16(v1[2], v1[3])};
                        *(u32x4*)(D + row * 512 + colb + 128 * bj) = o;
                    }
                }
        }
    }
};

struct EpiOut {
    static constexpr bool PERM = true;
    bf16_t* Y;
    __device__ __forceinline__ void operator()(const f32x4 (&acc)[2][2][4][2], const pg8::Unit& u, int wr, int wc, int fr, int fq) const {
        asm volatile("s_nop 15\n\ts_nop 15\n\ts_nop 15\n\ts_nop 15" ::: "memory");
        const int row0 = u.pm * 256 + wr * 64 + fr, col0 = u.pn * 256 + wc * 32 + 8 * fq;
#pragma unroll
        for (int ai = 0; ai < 2; ++ai)
#pragma unroll
            for (int m = 0; m < 4; ++m) {
                const size_t row = (size_t)(row0 + ai * 128 + m * 16);
#pragma unroll
                for (int bj = 0; bj < 2; ++bj) {
                    const f32x4 v0 = acc[ai][bj][m][0], v1 = acc[ai][bj][m][1];
                    u32x4 o = {cvt_pk_bf16(v0[0], v0[1]), cvt_pk_bf16(v0[2], v0[3]), cvt_pk_bf16(v1[0], v1[1]), cvt_pk_bf16(v1[2], v1[3])};
                    *(u32x4*)(Y + row * 1024 + col0 + 128 * bj) = o;
                }
            }
    }
};

__device__ void phase0(LAS unsigned char* lds, const Params& p, int it_lo, int it_hi) {
    const int tid = threadIdx.x;
    LAS float* fl = (LAS float*)lds;
    float* modp = (float*)(p.ws + WS_MODP);
    for (int it = it_lo + blockIdx.x; it < it_hi; it += gridDim.x) {
        if (it < 192) {
            const int cc = it % 48, kq = it / 48;
            LAS float* sil = fl; LAS float* red = fl + 2304;
            for (int i = tid; i < 2304; i += NTHR) { const int j = i >> 8, k = kq * 256 + (i & 255); const float v = (j < 8) ? p.c[j * 1024 + k] : p.c_ctx[k]; sil[i] = siluf_(v); }
            __syncthreads();
            const int n = tid & 63, ks = tid >> 6;
            const float* wp = p.w_mod + (size_t)(kq * 256 + ks * 32) * 3072 + cc * 64 + n;
            float a[9];
#pragma unroll
            for (int j = 0; j < 9; ++j) a[j] = 0.f;
#pragma unroll 8
            for (int kk = 0; kk < 32; ++kk) { const float w = wp[(size_t)kk * 3072];
#pragma unroll
                for (int j = 0; j < 9; ++j) a[j] += sil[j * 256 + ks * 32 + kk] * w; }
#pragma unroll
            for (int j = 0; j < 9; ++j) red[(ks * 9 + j) * 64 + n] = a[j];
            __syncthreads();
            for (int i = tid; i < 576; i += NTHR) { const int j = i >> 6, nn = i & 63; float s = 0.f;
#pragma unroll
                for (int k2 = 0; k2 < 8; ++k2) s += red[(k2 * 9 + j) * 64 + nn];
                modp[(kq * 9 + j) * 3072 + cc * 64 + nn] = s; }
            __syncthreads();
        } else {
            int t = it - 192; const float* W; bf16_t* WT; int N; bool isin;
            if (t < 1024) { W = p.w_in; WT = (bf16_t*)(p.ws + WS_WIN); N = 4096; isin = true; } else { t -= 1024; W = p.w_out; WT = (bf16_t*)(p.ws + WS_WOUT); N = 1024; isin = false; }
            const int kt = t & 15, nt = t >> 4;
            const int n = tid & 63, k0 = tid >> 6;
            const int ncol = nt * 64 + n; int src = ncol;
            if (isin && ncol < 2048) { const int pnn = ncol >> 8, cc = ncol & 255; const int type = ((cc >> 7) << 1) | ((cc >> 2) & 1); src = type * 512 + 64 * pnn + 16 * ((cc >> 5) & 3) + 4 * ((cc >> 3) & 3) + (cc & 3); }
            else if (isin && ncol >= 2560 && ncol < 3584) { const int mm = ncol - 2560, g = mm >> 3, i = mm & 7; src = (i < 4) ? 2560 + 4 * g + i : 3072 + 4 * g + (i - 4); }
#pragma unroll
            for (int ps = 0; ps < 8; ++ps) { const int k = ps * 8 + k0; fl[k * 65 + n] = W[(size_t)(kt * 64 + k) * N + src]; }
            __syncthreads();
            const int nn = tid >> 3, k8 = tid & 7;
            float v[8];
#pragma unroll
            for (int j = 0; j < 8; ++j) v[j] = fl[(k8 * 8 + j) * 65 + nn];
            u32x4 o = {cvt_pk_bf16(v[0], v[1]), cvt_pk_bf16(v[2], v[3]), cvt_pk_bf16(v[4], v[5]), cvt_pk_bf16(v[6], v[7])};
            *(u32x4*)(WT + (size_t)(nt * 64 + nn) * 1024 + kt * 64 + k8 * 8) = o;
            __syncthreads();
        }
    }
}

__device__ void phase1(LAS unsigned char* lds, const Params& p) {
    const int tid = threadIdx.x, w = tid >> 6, lane = tid & 63;
    LAS float* mv = (LAS float*)lds;
    const float* modp = (const float*)(p.ws + WS_MODP);
    bf16_t* A = (bf16_t*)(p.ws + WS_A);
    const int ngrp = NROWS / 8;
    const int g0 = (int)((long)blockIdx.x * ngrp / gridDim.x), g1 = (int)((long)(blockIdx.x + 1) * ngrp / gridDim.x);
    int curj = -1;
    for (int g = g0; g < g1; ++g) {
        const int row0 = g * 8; const int j = row0 < NLAT ? (row0 >> 12) : 8;
        if (j != curj) {
            __syncthreads();
            for (int i = tid; i < 1024; i += NTHR) { float sh = p.b_mod[i], sc = p.b_mod[1024 + i];
#pragma unroll
                for (int q = 0; q < 4; ++q) { sh += modp[(q * 9 + j) * 3072 + i]; sc += modp[(q * 9 + j) * 3072 + 1024 + i]; }
                mv[i] = p.norm_g[i] * (1.f + sc); mv[1024 + i] = sh; }
            __syncthreads(); curj = j;
        }
        const int row = row0 + w;
        const float* xr = row < NLAT ? p.x + (size_t)row * 1024 : p.ctx + (size_t)(row - NLAT) * 1024;
        f32x4 v[4]; float ss = 0.f;
#pragma unroll
        for (int c = 0; c < 4; ++c) { v[c] = *(const f32x4*)(xr + c * 256 + lane * 4); ss += v[c][0] * v[c][0] + v[c][1] * v[c][1] + v[c][2] * v[c][2] + v[c][3] * v[c][3]; }
#pragma unroll
        for (int m = 32; m >= 1; m >>= 1) ss += __shfl_xor(ss, m);
        const float rs = rsqrtf(ss * (1.f / 1024.f) + EPS);
#pragma unroll
        for (int c = 0; c < 4; ++c) { const int k = c * 256 + lane * 4; const f32x4 m0 = *(const LAS f32x4*)(mv + k), m1 = *(const LAS f32x4*)(mv + 1024 + k);
            const f32x4 a = v[c] * rs * m0 + m1; u32x2 o = {cvt_pk_bf16(a[0], a[1]), cvt_pk_bf16(a[2], a[3])}; *(u32x2*)(A + (size_t)row * 1024 + k) = o; }
    }
}

#define MFMA16(a, b, c) __builtin_amdgcn_mfma_f32_16x16x32_bf16((a), (b), (c), 0, 0, 0)
__device__ __forceinline__ int scan_cid(int n, int dir, int b) { return n < 4 ? 512 + b * 4 + (dir ? 3 - n : n) : b * 64 + (dir ? 67 - n : n - 4); }
#define SCAN_BAR() asm volatile("s_waitcnt lgkmcnt(0)\n\ts_barrier" ::: "memory")
#define SB_() __builtin_amdgcn_sched_barrier(0)
typedef short s16x4 __attribute__((ext_vector_type(4)));
__device__ __forceinline__ bf16x8 tr_pair(const LAS bf16_t* img, int stride, int r0a, int r0b, int c0, int ln) {
    const int q = ln >> 2, p = ln & 3;
    const s16x4 a = __builtin_amdgcn_ds_read_tr16_b64_v4i16((LAS s16x4*)(img + (r0a + q) * stride + c0 + 4 * p));
    const s16x4 b = __builtin_amdgcn_ds_read_tr16_b64_v4i16((LAS s16x4*)(img + (r0b + q) * stride + c0 + 4 * p));
    return __builtin_shufflevector(a, b, 0, 1, 2, 3, 4, 5, 6, 7);
}
__device__ void scan_phase(LAS unsigned char* lds, const Params& p) {
    const int tid = threadIdx.x, w = __builtin_amdgcn_readfirstlane(tid >> 6), lane = tid & 63, ln = lane & 15, lq = lane >> 4;
    constexpr int QST = 136, VST = 36;
    constexpr int OFF_KS = 17408, OFF_V = 34816, BUFB = 39424;
    LAS bf16_t* Sr = (LAS bf16_t*)(lds + 2 * BUFB);
    LAS float* scs = (LAS float*)(lds + 2 * BUFB + 9216);
    bf16_t* O = (bf16_t*)p.out;
    bf16_t* Odummy = (bf16_t*)(p.ws + WS_A) + (size_t)blockIdx.x * 64 * 512;
    const float* RT = (const float*)(p.ws + WS_RT);
    const int eb = w & 1, tb = w >> 1;
    for (int item = blockIdx.x; item < 256; item += gridDim.x) {
        const int seq = (item & 7) + 8 * (item >> 5), es = (item >> 3) & 3;
        const int dir = seq & 1, h = (seq >> 1) & 3, b = seq >> 3;
        const char* Qx = (const char*)((const bf16_t*)(p.ws + (dir ? WS_QB : WS_QF)) + h * 128);
        const char* Kx = (const char*)((const bf16_t*)(p.ws + (dir ? WS_KB : WS_KF)) + h * 128);
        const char* Vx = (const char*)((const bf16_t*)(p.ws + WS_V) + h * 128 + es * 32);
        const char* Rx = (const char*)(RT + (size_t)dir * NCHUNK * 512 + h * 128);
        const char* Tx = (const char*)(RT + (size_t)(2 + dir) * NCHUNK * 512 + h * 128);
        const unsigned qoff0 = (unsigned)((dir ? 63 - (tid >> 4) : (tid >> 4)) * 1024 + (tid & 15) * 16), qstep = dir ? (unsigned)-32768 : 32768u;
        const unsigned voff = (unsigned)((dir ? 63 - (tid >> 3) : (tid >> 3)) * 1024 + (tid & 7) * 8), roff = (unsigned)(tid & 127) * 4u;
        f32x4 S[2] = {(f32x4){0.f, 0.f, 0.f, 0.f}, (f32x4){0.f, 0.f, 0.f, 0.f}};
        float tailp = 0.f;
        u32x4 k4A[2], k4B[2], k4C[2], k4D[2]; u32x4 q4A[2], q4B[2], q4C[2], q4D[2]; u32x2 v4A, v4B, v4C, v4D; float rvA, tlA, rvB, tlB, rvC, tlC, rvD, tlD;
#define SCAN_LOAD(n, k4, q4, v4, rv, tl) do { const size_t cb_ = (size_t)scan_cid((n), dir, b) * 65536; const size_t rb_ = (size_t)scan_cid((n), dir, b) * 2048; SB_(); \
            _Pragma("unroll") for (int i = 0; i < 2; ++i) { k4[i] = *(const u32x4*)(Kx + cb_ + (qoff0 + (unsigned)i * qstep)); SB_(); } \
            _Pragma("unroll") for (int i = 0; i < 2; ++i) { q4[i] = *(const u32x4*)(Qx + cb_ + (qoff0 + (unsigned)i * qstep)); SB_(); } \
            v4 = *(const u32x2*)(Vx + cb_ + voff); SB_(); rv = *(const float*)(Rx + rb_ + roff); SB_(); tl = *(const float*)(Tx + rb_ + roff); SB_(); } while (0)
#define SCAN_STAGE(bf, k4, q4, v4, rv, tl) do { LAS unsigned char* B_ = lds + (bf) * BUFB; \
            _Pragma("unroll") for (int i = 0; i < 2; ++i) { const int pc = tid + 512 * i; *(LAS u32x4*)(B_ + ((pc >> 4) * QST + (pc & 15) * 8) * 2) = q4[i]; *(LAS u32x4*)(B_ + OFF_KS + ((pc >> 4) * QST + (pc & 15) * 8) * 2) = k4[i]; } \
            *(LAS u32x2*)(B_ + OFF_V + ((tid >> 3) * VST + (tid & 7) * 4) * 2) = v4; \
            if (tid < 128) { scs[(bf) * 128 + tid] = __expf(rv + tailp); tailp = tl; } } while (0)
#define SCAN_MAT(bf, n) do { LAS unsigned char* B_ = lds + (bf) * BUFB; LAS bf16_t* Qs = (LAS bf16_t*)B_; LAS bf16_t* Ks = (LAS bf16_t*)(B_ + OFF_KS); LAS bf16_t* Vs = (LAS bf16_t*)(B_ + OFF_V); \
            _Pragma("unroll") for (int ti = 0; ti < 2; ++ti) { const int db = 2 * tb + ti; const float scv = scs[(bf) * 128 + 16 * db + ln]; S[ti] *= scv; \
                *(LAS u32x2*)(Sr + (16 * db + ln) * VST + 16 * eb + 4 * lq) = (u32x2){cvt_pk_bf16(S[ti][0], S[ti][1]), cvt_pk_bf16(S[ti][2], S[ti][3])}; } \
            bf16x8 Bq[4]; f32x4 pt[4]; \
            _Pragma("unroll") for (int ks = 0; ks < 4; ++ks) Bq[ks] = *(const LAS bf16x8*)(Qs + (16 * tb + ln) * QST + ks * 32 + lq * 8); \
            _Pragma("unroll") for (int sb = 0; sb < 4; ++sb) { pt[sb] = (f32x4){0.f, 0.f, 0.f, 0.f}; \
                if (sb <= tb) { f32x4 a = (f32x4){0.f, 0.f, 0.f, 0.f}; \
                    _Pragma("unroll") for (int ks = 0; ks < 4; ++ks) { const bf16x8 Ak = *(const LAS bf16x8*)(Ks + (16 * sb + ln) * QST + ks * 32 + lq * 8); a = MFMA16(Ak, Bq[ks], a); } \
                    if (sb == tb) { _Pragma("unroll") for (int i = 0; i < 4; ++i) if (4 * lq + i > ln) a[i] = 0.f; } \
                    pt[sb] = a; } } \
            SCAN_BAR(); \
            f32x4 o = (f32x4){0.f, 0.f, 0.f, 0.f}; \
            _Pragma("unroll") for (int ks = 0; ks < 4; ++ks) { const bf16x8 As = tr_pair(Sr, VST, 32 * ks + 8 * lq, 32 * ks + 8 * lq + 4, 16 * eb, ln); o = MFMA16(As, Bq[ks], o); } \
            _Pragma("unroll") for (int g = 0; g < 2; ++g) { if (2 * g <= tb) { \
                    const bf16x8 Av = tr_pair(Vs, VST, 32 * g + 4 * lq, 32 * g + 16 + 4 * lq, 16 * eb, ln); \
                    const u32x4 bp = {cvt_pk_bf16_mfma(pt[2 * g][0], pt[2 * g][1]), cvt_pk_bf16(pt[2 * g][2], pt[2 * g][3]), cvt_pk_bf16(pt[2 * g + 1][0], pt[2 * g + 1][1]), cvt_pk_bf16(pt[2 * g + 1][2], pt[2 * g + 1][3])}; \
                    o = MFMA16(Av, __builtin_bit_cast(bf16x8, bp), o); } } \
            { const int pos = 16 * tb + ln; const size_t row = (size_t)scan_cid((n), dir, b) * 64 + (dir ? 63 - pos : pos); \
              bf16_t* dst = ((n) >= 4) ? O + ((size_t)dir * NLAT + row) * 512 + h * 128 + es * 32 : Odummy + (size_t)pos * 512;     \
              *(u32x2*)(dst + 16 * eb + 4 * lq) = (u32x2){cvt_pk_bf16_mfma(o[0], o[1]), cvt_pk_bf16_mfma(o[2], o[3])}; } \
            _Pragma("unroll") for (int k2i = 0; k2i < 2; ++k2i) { const bf16x8 Av = tr_pair(Vs, VST, 32 * k2i + 8 * lq, 32 * k2i + 8 * lq + 4, 16 * eb, ln); \
                _Pragma("unroll") for (int ti = 0; ti < 2; ++ti) { const bf16x8 Bk = tr_pair(Ks, QST, 32 * k2i + 8 * lq, 32 * k2i + 8 * lq + 4, 16 * (2 * tb + ti), ln); S[ti] = MFMA16(Av, Bk, S[ti]); } } \
            } while (0)
        SCAN_LOAD(0, k4A, q4A, v4A, rvA, tlA); SCAN_LOAD(1, k4B, q4B, v4B, rvB, tlB); SCAN_LOAD(2, k4C, q4C, v4C, rvC, tlC); SCAN_LOAD(3, k4D, q4D, v4D, rvD, tlD);
        SCAN_STAGE(0, k4A, q4A, v4A, rvA, tlA); SCAN_LOAD(4, k4A, q4A, v4A, rvA, tlA);
        SCAN_BAR();
#pragma unroll 1
        for (int n0 = 0; n0 < 68; n0 += 4) {
            SCAN_STAGE(1, k4B, q4B, v4B, rvB, tlB); SCAN_LOAD(min(n0 + 5, 67), k4B, q4B, v4B, rvB, tlB); SCAN_MAT(0, n0); SCAN_BAR();
            SCAN_STAGE(0, k4C, q4C, v4C, rvC, tlC); SCAN_LOAD(min(n0 + 6, 67), k4C, q4C, v4C, rvC, tlC); SCAN_MAT(1, n0 + 1); SCAN_BAR();
            SCAN_STAGE(1, k4D, q4D, v4D, rvD, tlD); SCAN_LOAD(min(n0 + 7, 67), k4D, q4D, v4D, rvD, tlD); SCAN_MAT(0, n0 + 2); SCAN_BAR();
            SCAN_STAGE(0, k4A, q4A, v4A, rvA, tlA); SCAN_LOAD(min(n0 + 8, 67), k4A, q4A, v4A, rvA, tlA); SCAN_MAT(1, n0 + 3); SCAN_BAR();
        }
#undef SCAN_LOAD
#undef SCAN_STAGE
#undef SCAN_MAT
    }
}

__device__ void conv_phase(LAS unsigned char* lds, const Params& p) {
    const int tid = threadIdx.x, w = tid >> 6, lane = tid & 63;
    LAS float* wl = (LAS float*)lds;
    for (int i = tid; i < 32 * 128; i += NTHR) ((LAS f32x4*)wl)[i] = (i < 31 * 128) ? ((const f32x4*)p.conv_w)[i] : (f32x4){0.f, 0.f, 0.f, 0.f};
    __syncthreads();
    const bf16_t* Gp = (const bf16_t*)(p.ws + WS_G); const bf16_t* GAp = (const bf16_t*)(p.ws + WS_GA); const bf16_t* GBp = (const bf16_t*)(p.ws + WS_GB);
    const bf16_t* O = (const bf16_t*)p.out;
    bf16_t* A2 = (bf16_t*)(p.ws + WS_A);
    const int half = lane >> 5, ch0 = lane * 8;
    for (int it = blockIdx.x * 8 + w; it < 8192; it += gridDim.x * 8) {
        const int b = it >> 10, r0 = ((it >> 5) & 31) * 2, c0 = (it & 31) * 2;
        float acc[4][8];
        const char* Pb = (const char*)Gp;
        const int base = half ? r0 : c0;
        const unsigned stepB = (half ? 64u : 1u) * 1024u;
#pragma unroll 1
        for (int line = 0; line < 2; ++line) {
            const int tok0 = half ? (c0 + line) : (r0 + line) * 64;
            const unsigned offb = (unsigned)((b * 4096 + tok0) * 512 + ch0) * 2u;
            asm volatile("" ::: "memory");
            float cur[2][8];
#pragma unroll
            for (int a = 0; a < 2; ++a)
#pragma unroll
                for (int c = 0; c < 8; ++c) cur[a][c] = 0.f;
            float Wp[8];
#pragma unroll
            for (int c = 0; c < 8; ++c) Wp[c] = 0.f;
#pragma unroll 1
            for (int hb = 0; hb < 4; ++hb) {
                u32x4 raw[8];
#pragma unroll
                for (int q = 0; q < 8; ++q) {
                    const int xx = base - 15 + hb * 8 + q;
                    const int xc = min(max(xx, 0), 63);
                    const u32x4 r = *(const u32x4*)(Pb + (offb + (unsigned)xc * stepB));
                    const bool ok = (xx == xc);
                    raw[q] = (u32x4){ok ? r[0] : 0u, ok ? r[1] : 0u, ok ? r[2] : 0u, ok ? r[3] : 0u};
                }
                const LAS float* wrow = wl + hb * 8 * 512 + ch0;
#pragma unroll
                for (int q = 0; q < 8; ++q) {
                    const float in[8] = {bf_lo(raw[q][0]), bf_hi(raw[q][0]), bf_lo(raw[q][1]), bf_hi(raw[q][1]), bf_lo(raw[q][2]), bf_hi(raw[q][2]), bf_lo(raw[q][3]), bf_hi(raw[q][3])};
                    const f32x4 wa = *(const LAS f32x4*)(wrow + q * 512), wb = *(const LAS f32x4*)(wrow + q * 512 + 4);
                    const float Wc[8] = {wa[0], wa[1], wa[2], wa[3], wb[0], wb[1], wb[2], wb[3]};
#pragma unroll
                    for (int c = 0; c < 8; ++c) { cur[0][c] += Wc[c] * in[c]; cur[1][c] += Wp[c] * in[c]; Wp[c] = Wc[c]; }
                }
            }
#pragma unroll
            for (int j = 0; j < 2; ++j)
#pragma unroll
                for (int c = 0; c < 8; ++c) { if (line == 0) acc[j][c] = cur[j][c]; else acc[2 + j][c] = cur[j][c]; }
        }
        float cbv[8], lg[8], lbv[8], hg[8];
        { const f32x4 a0 = *(const f32x4*)(p.conv_b + ch0), a1 = *(const f32x4*)(p.conv_b + ch0 + 4), b0 = *(const f32x4*)(p.conv_ln_g + ch0), b1 = *(const f32x4*)(p.conv_ln_g + ch0 + 4);
          const f32x4 d0 = *(const f32x4*)(p.conv_ln_b + ch0), d1 = *(const f32x4*)(p.conv_ln_b + ch0 + 4), e0 = *(const f32x4*)(p.hgrn_norm_g + ch0), e1 = *(const f32x4*)(p.hgrn_norm_g + ch0 + 4);
#pragma unroll
          for (int c = 0; c < 4; ++c) { cbv[c] = a0[c]; cbv[4 + c] = a1[c]; lg[c] = b0[c]; lg[4 + c] = b1[c]; lbv[c] = d0[c]; lbv[4 + c] = d1[c]; hg[c] = e0[c]; hg[4 + c] = e1[c]; } }
#pragma unroll
        for (int lr = 0; lr < 2; ++lr)
#pragma unroll
            for (int lc = 0; lc < 2; ++lc) {
                const size_t token = (size_t)b * 4096 + (r0 + lr) * 64 + (c0 + lc);
                float v[8]; float s1 = 0.f, s2 = 0.f;
#pragma unroll
                for (int c = 0; c < 8; ++c) { v[c] = (half ? acc[lc * 2 + lr][c] : acc[lr * 2 + lc][c]) + cbv[c]; s1 += v[c]; s2 += v[c] * v[c]; }
#pragma unroll
                for (int m = 32; m >= 1; m >>= 1) { s1 += __shfl_xor(s1, m); s2 += __shfl_xor(s2, m); }
                const float mean = s1 * (1.f / 512.f), var = fmaxf(s2 * (1.f / 512.f) - mean * mean, 0.f), rstd = rsqrtf(var + EPS);
                const u32x4 gbr = *(const u32x4*)(GBp + token * 512 + ch0);
                const float gbv[8] = {bf_lo(gbr[0]), bf_hi(gbr[0]), bf_lo(gbr[1]), bf_hi(gbr[1]), bf_lo(gbr[2]), bf_hi(gbr[2]), bf_lo(gbr[3]), bf_hi(gbr[3])};
                float y[8];
#pragma unroll
                for (int c = 0; c < 8; ++c) { const float t = (v[c] - mean) * rstd * lg[c] + lbv[c]; y[c] = siluf_(t) * gbv[c]; }
                u32x4 ob = {cvt_pk_bf16(y[0], y[1]), cvt_pk_bf16(y[2], y[3]), cvt_pk_bf16(y[4], y[5]), cvt_pk_bf16(y[6], y[7])};
                *(u32x4*)(A2 + token * 1024 + 512 + ch0) = ob;
                const u32x4 fo = *(const u32x4*)(O + token * 512 + ch0), bo = *(const u32x4*)(O + ((size_t)NLAT + token) * 512 + ch0);
                float ov[8]; float ss = 0.f;
#pragma unroll
                for (int c = 0; c < 4; ++c) { ov[2 * c] = bf_lo(fo[c]) + bf_lo(bo[c]); ov[2 * c + 1] = bf_hi(fo[c]) + bf_hi(bo[c]); }
#pragma unroll
                for (int c = 0; c < 8; ++c) ss += ov[c] * ov[c];
                ss += __shfl_xor(ss, 1); ss += __shfl_xor(ss, 2); ss += __shfl_xor(ss, 4); ss += __shfl_xor(ss, 8);
                const float rn = rsqrtf(ss * (1.f / 128.f) + EPS);
                const u32x4 gar = *(const u32x4*)(GAp + token * 512 + ch0);
                const float gav[8] = {bf_lo(gar[0]), bf_hi(gar[0]), bf_lo(gar[1]), bf_hi(gar[1]), bf_lo(gar[2]), bf_hi(gar[2]), bf_lo(gar[3]), bf_hi(gar[3])};
                float z[8];
#pragma unroll
                for (int c = 0; c < 8; ++c) z[c] = ov[c] * rn * hg[c] * gav[c];
                u32x4 oa = {cvt_pk_bf16(z[0], z[1]), cvt_pk_bf16(z[2], z[3]), cvt_pk_bf16(z[4], z[5]), cvt_pk_bf16(z[6], z[7])};
                *(u32x4*)(A2 + token * 1024 + ch0) = oa;
            }
    }
}

__device__ void final_phase(const Params& p) {
    const int tid = threadIdx.x, w = tid >> 6, lane = tid & 63;
    const float* modp = (const float*)(p.ws + WS_MODP);
    const bf16_t* Y = (const bf16_t*)(p.ws + WS_QF);
    const int rows_per = NLAT / gridDim.x;
    for (int r0 = blockIdx.x * rows_per; r0 < NLAT; r0 += gridDim.x * rows_per) {
        const int rend = min(r0 + rows_per, NLAT);
        int curb = -1; f32x4 gt[4], g[4];
#pragma unroll
        for (int c = 0; c < 4; ++c) { g[c] = *(const f32x4*)(p.final_norm_g + c * 256 + lane * 4); gt[c] = (f32x4){0.f, 0.f, 0.f, 0.f}; }
        for (int row = r0 + w * 2; row < rend; row += 16) {
            const int b = row >> 12;
            if (b != curb) { curb = b;
#pragma unroll
                for (int c = 0; c < 4; ++c) { f32x4 t = *(const f32x4*)(p.b_mod + 2048 + c * 256 + lane * 4);
#pragma unroll
                    for (int q = 0; q < 4; ++q) t += *(const f32x4*)(modp + (q * 9 + b) * 3072 + 2048 + c * 256 + lane * 4);
                    gt[c] = t; } }
            const float* xp = p.x + (size_t)row * 1024; const bf16_t* yp = Y + (size_t)row * 1024; float* op = p.out + (size_t)row * 1024;
            f32x4 h0[4], h1[4]; float s0 = 0.f, s1 = 0.f;
#pragma unroll
            for (int c = 0; c < 4; ++c) {
                const f32x4 x0 = *(const f32x4*)(xp + c * 256 + lane * 4), x1 = *(const f32x4*)(xp + 1024 + c * 256 + lane * 4);
                const u32x2 y0 = *(const u32x2*)(yp + c * 256 + lane * 4), y1 = *(const u32x2*)(yp + 1024 + c * 256 + lane * 4);
                h0[c] = x0 + gt[c] * (f32x4){bf_lo(y0[0]), bf_hi(y0[0]), bf_lo(y0[1]), bf_hi(y0[1])};
                h1[c] = x1 + gt[c] * (f32x4){bf_lo(y1[0]), bf_hi(y1[0]), bf_lo(y1[1]), bf_hi(y1[1])};
                s0 += h0[c][0] * h0[c][0] + h0[c][1] * h0[c][1] + h0[c][2] * h0[c][2] + h0[c][3] * h0[c][3];
                s1 += h1[c][0] * h1[c][0] + h1[c][1] * h1[c][1] + h1[c][2] * h1[c][2] + h1[c][3] * h1[c][3];
            }
#pragma unroll
            for (int m = 32; m >= 1; m >>= 1) { s0 += __shfl_xor(s0, m); s1 += __shfl_xor(s1, m); }
            const float rs0 = rsqrtf(s0 * (1.f / 1024.f) + EPS), rs1 = rsqrtf(s1 * (1.f / 1024.f) + EPS);
#pragma unroll
            for (int c = 0; c < 4; ++c) { *(f32x4*)(op + c * 256 + lane * 4) = h0[c] * rs0 * g[c]; *(f32x4*)(op + 1024 + c * 256 + lane * 4) = h1[c] * rs1 * g[c]; }
        }
    }
}

__global__ void __launch_bounds__(NTHR, 2) hymba_fwd(Params p) {
    extern __shared__ __attribute__((aligned(16))) unsigned char lds_raw[];
    LAS unsigned char* lds = (LAS unsigned char*)lds_raw;
    const int lo = p.ph_lo, hi = p.ph_hi;
#define IN(k) (lo <= (k) && (k) < hi)
#if N_LAUNCHES == 1
    volatile LAS unsigned* bst = (volatile LAS unsigned*)(lds + 131072);
    if (threadIdx.x < 4) bst[threadIdx.x] = 0u;
    __syncthreads();
    const XcdBarrier bar = xcd_barrier_post((unsigned*)(p.ws + WS_BAR), bst);
#define SEAM(k) do { if (IN(k) && IN((k) + 1)) xcd_barrier(bar); } while (0)
#else
#define SEAM(k) do { } while (0)
#endif
#ifndef DUP_PHASE
#define DUP_PHASE -1
#endif
    if (IN(0)) phase0(lds, p, 0, 192 + 1280);
    SEAM(0);
    if (IN(1)) phase1(lds, p);
    SEAM(1);
    if (IN(2)) {
        pg8::Gemm g{(const bf16_t*)(p.ws + WS_A), (const bf16_t*)(p.ws + WS_WIN), NROWS, 4096, 1024};
        pg8::InOrder S; S.init(NLAT, 4096, gridDim.x, blockIdx.x);
        EpiIn E{p.ws, p.lb_logits};
#pragma unroll 1
        for (int rep = 0; rep < (DUP_PHASE == 2 ? 2 : 1); ++rep) pg8::gemm_phase<EpiIn, pg8::InOrder>(lds, g, S, E);
    }
    SEAM(2);
    if (IN(3)) {
#pragma unroll 1
        for (int rep = 0; rep < (DUP_PHASE == 3 ? 2 : 1); ++rep) scan_phase(lds, p);
    }
    SEAM(3);
    if (IN(4)) { conv_phase(lds, p); if (DUP_PHASE == 4) { __syncthreads(); conv_phase(lds, p); } }
    SEAM(4);
    if (IN(5)) {
        pg8::Gemm g{(const bf16_t*)(p.ws + WS_A), (const bf16_t*)(p.ws + WS_WOUT), NLAT, 1024, 1024};
        pg8::StaticOrder S; S.init(NLAT, 1024, gridDim.x, blockIdx.x);
        EpiOut E{(bf16_t*)(p.ws + WS_QF)};
#pragma unroll 1
        for (int rep = 0; rep < (DUP_PHASE == 5 ? 2 : 1); ++rep) pg8::gemm_phase<EpiOut, pg8::StaticOrder>(lds, g, S, E);
    }
    SEAM(5);
    if (IN(6)) final_phase(p);
}

extern "C" void kernel_launch(void* const* d_in, const int* in_sizes, int n_in, void* d_out, int out_size, void* d_ws, size_t ws_size, hipStream_t stream) {
    static int grid = 0;
    if (grid == 0) {
        int dev = 0, cus = 0, per_cu = 0;
        hipGetDevice(&dev);
        hipDeviceGetAttribute(&cus, hipDeviceAttributeMultiprocessorCount, dev);
        hipFuncSetAttribute((const void*)hymba_fwd, hipFuncAttributeMaxDynamicSharedMemorySize, LDS_BYTES);
        hipOccupancyMaxActiveBlocksPerMultiprocessor(&per_cu, (const void*)hymba_fwd, NTHR, LDS_BYTES);
        if (per_cu < 1) { fprintf(stderr, "kernel_launch: occupancy query says %d blocks/CU\n", per_cu); per_cu = 1; }
        grid = cus * per_cu;
        if (ws_size < WS_END) { fprintf(stderr, "kernel_launch: workspace too small (%zu < %zu)\n", ws_size, (size_t)WS_END); grid = -1; }
    }
    if (grid < 0) return;
    Params p{};
    p.x = (const float*)d_in[0]; p.c = (const float*)d_in[1]; p.ctx = (const float*)d_in[2]; p.c_ctx = (const float*)d_in[3]; p.norm_g = (const float*)d_in[4];
    p.w_mod = (const float*)d_in[5]; p.b_mod = (const float*)d_in[6]; p.w_in = (const float*)d_in[7]; p.lb_logits = (const float*)d_in[8]; p.hgrn_norm_g = (const float*)d_in[9];
    p.conv_w = (const float*)d_in[10]; p.conv_b = (const float*)d_in[11]; p.conv_ln_g = (const float*)d_in[12]; p.conv_ln_b = (const float*)d_in[13]; p.w_out = (const float*)d_in[14];
    p.final_norm_g = (const float*)d_in[15];
    p.out = (float*)d_out; p.ws = (unsigned char*)d_ws;
#if N_LAUNCHES == 1
    p.ph_lo = 0; p.ph_hi = 7;
    hipMemsetAsync((unsigned char*)d_ws + WS_BAR, 0, XCD_BAR_WORDS * 4, stream);
    void* args[] = {&p};
    hipError_t e = hipLaunchCooperativeKernel((const void*)hymba_fwd, dim3(grid), dim3(NTHR), args, LDS_BYTES, stream);
    if (e != hipSuccess) fprintf(stderr, "cooperative launch failed: %s (grid %d)\n", hipGetErrorString(e), grid);
#else
    for (int ph = 0; ph < 7; ++ph) { p.ph_lo = ph; p.ph_hi = ph + 1; hipLaunchKernelGGL(hymba_fwd, dim3(grid), dim3(NTHR), LDS_BYTES, stream, p); }
#endif
}
```

```cpp
#include <hip/hip_runtime.h>
#include <hip/hip_cooperative_groups.h>
#include <cstdio>
namespace cg = cooperative_groups;

#ifndef N_LAUNCHES
#define N_LAUNCHES 1
#endif

#define LAS __attribute__((address_space(3)))
typedef unsigned short bf16_t;
typedef short bf16x8 __attribute__((ext_vector_type(8)));
typedef float f32x4 __attribute__((ext_vector_type(4)));
typedef float f32x2 __attribute__((ext_vector_type(2)));
typedef unsigned u32x4 __attribute__((ext_vector_type(4)));
typedef unsigned u32x2 __attribute__((ext_vector_type(2)));

constexpr int NTHR = 512;
constexpr int DM = 1024, NLAT = 32768, NROWS = 34816;
constexpr int NCHUNK = NROWS / 64;
constexpr float EPS = 1e-6f;
constexpr int LDS_BYTES = 131072 + 16;

constexpr size_t WS_WIN = 0;
constexpr size_t WS_WOUT = 8388608;
constexpr size_t WS_MODP = 10485760;
constexpr size_t WS_RSS = 11010048;
constexpr size_t WS_BAR = 13107200;
constexpr size_t WS_A = 13631488;
constexpr size_t SZ_S = (size_t)NROWS * 512 * 2, SZ_L = (size_t)NLAT * 512 * 2;
constexpr size_t WS_QF = WS_A + (size_t)NROWS * 1024 * 2;
constexpr size_t WS_QB = WS_QF + SZ_S;
constexpr size_t WS_KF = WS_QB + SZ_S;
constexpr size_t WS_KB = WS_KF + SZ_S;
constexpr size_t WS_V = WS_KB + SZ_S;
constexpr size_t WS_GA = WS_V + SZ_S;
constexpr size_t WS_G = WS_GA + SZ_L;
constexpr size_t WS_GB = WS_G + SZ_L;
constexpr size_t WS_RT = WS_GB + SZ_L;
constexpr size_t WS_END = WS_RT + (size_t)2 * 2 * NCHUNK * 512 * 4;

struct Params {
    const float *x, *c, *ctx, *c_ctx, *norm_g, *w_mod, *b_mod, *w_in, *lb_logits, *hgrn_norm_g, *conv_w, *conv_b, *conv_ln_g, *conv_ln_b, *w_out, *final_norm_g;
    float* out; unsigned char* ws; int ph_lo, ph_hi;
};

__device__ __forceinline__ unsigned cvt_pk_bf16(float lo, float hi) { unsigned r; asm volatile("v_cvt_pk_bf16_f32 %0, %1, %2" : "=v"(r) : "v"(lo), "v"(hi)); return r; }
__device__ __forceinline__ unsigned cvt_pk_bf16_mfma(float lo, float hi) { unsigned r; asm volatile("s_nop 15\n\ts_nop 7\n\tv_cvt_pk_bf16_f32 %0, %1, %2" : "=v"(r) : "v"(lo), "v"(hi)); return r; }
__device__ __forceinline__ float bf_lo(unsigned u) { return __uint_as_float(u << 16); }
__device__ __forceinline__ float bf_hi(unsigned u) { return __uint_as_float(u & 0xffff0000u); }
__device__ __forceinline__ float sigmoidf_(float v) { return __builtin_amdgcn_rcpf(1.f + __expf(-v)); }
__device__ __forceinline__ float siluf_(float v) { return v * __builtin_amdgcn_rcpf(1.f + __expf(-v)); }


#define XB_TMO      128
#define XB_XCNT(j)  (256  + 64 * (j))
#define XB_XSUB(j)  (1280 + 64 * (j))
#define XB_XGEN(j)  (2304 + 64 * (j))
#define XB_TOP      3328
#define XB_TOPGEN   3392
#define XCD_BAR_WORDS 3456
#define XB_SPIN_CAP (1u << 18)
__device__ __forceinline__ unsigned xb_ld(unsigned* p)              { return __hip_atomic_load(p, __ATOMIC_RELAXED, __HIP_MEMORY_SCOPE_AGENT); }
__device__ __forceinline__ unsigned xb_add(unsigned* p, unsigned v) { return __hip_atomic_fetch_add(p, v, __ATOMIC_RELAXED, __HIP_MEMORY_SCOPE_AGENT); }
__device__ __forceinline__ unsigned xb_xcc_id() { return (unsigned)__builtin_amdgcn_s_getreg((3 << 11) | 20) & 0xFu; }
#define XB_SPIN(cond, bar) do { unsigned _sp = 0; while (cond) { __builtin_amdgcn_s_sleep(1); \
    if ((++_sp & 255u) == 0u) { if (xb_ld(&(bar)[XB_TMO])) break; if (_sp > XB_SPIN_CAP) { atomicAdd(&(bar)[XB_TMO], 1u); break; } } } } while (0)
struct XcdBarrier { unsigned* bar; unsigned x; volatile LAS unsigned* st; };
__device__ __forceinline__ XcdBarrier xcd_barrier_post(unsigned* bar, volatile LAS unsigned* st) {
    XcdBarrier b; b.bar = bar; b.x = xb_xcc_id(); b.st = st;
    if (threadIdx.x == 0) (void)xb_add(&bar[XB_XCNT(b.x)], 1u);
    return b;
}
__device__ __forceinline__ void xcd_barrier_complete(unsigned* bar, unsigned x, unsigned& nloc, unsigned& nx) {
    const unsigned G = gridDim.x * gridDim.y * gridDim.z;
    unsigned sum, cnt, mine, sp = 0u;
    for (;;) {
        sum = 0u; cnt = 0u; mine = 0u;
#pragma unroll
        for (unsigned j = 0; j < 16; ++j) { const unsigned c = xb_ld(&bar[XB_XCNT(j)]); sum += c; cnt += (c > 0u) ? 1u : 0u; mine = (j == x) ? c : mine; }
        if (sum == G) break;
        __builtin_amdgcn_s_sleep(1);
        if ((++sp & 255u) == 0u) { if (xb_ld(&bar[XB_TMO])) break; if (sp > XB_SPIN_CAP) { atomicAdd(&bar[XB_TMO], 1u); break; } }
    }
    nloc = mine > 0u ? mine : 1u; nx = cnt > 0u ? cnt : 1u;
}
__device__ __forceinline__ void xcd_barrier(const XcdBarrier& b) {
    asm volatile("s_waitcnt vmcnt(0)" ::: "memory");
    __syncthreads();
    if (threadIdx.x == 0) {
        unsigned* bar = b.bar;
        __builtin_amdgcn_s_waitcnt(0);
        unsigned nloc = b.st[0], nx = b.st[1];
        if (nloc == 0u) { xcd_barrier_complete(bar, b.x, nloc, nx); b.st[0] = nloc; b.st[1] = nx; }
        const unsigned old = xb_add(&bar[XB_XSUB(b.x)], 1u);
        const unsigned gen = old / nloc;
        if (old + 1u == (gen + 1u) * nloc) {
            __builtin_amdgcn_fence(__ATOMIC_RELEASE, "agent");
            asm volatile("s_waitcnt vmcnt(0)" ::: "memory");
            const unsigned og = xb_add(&bar[XB_TOP], 1u);
            const unsigned tg = og / nx;
            if (og + 1u == (tg + 1u) * nx) xb_add(&bar[XB_TOPGEN], 1u);
            else XB_SPIN(xb_ld(&bar[XB_TOPGEN]) == tg, bar);
            __builtin_amdgcn_fence(__ATOMIC_ACQUIRE, "agent");
            xb_add(&bar[XB_XGEN(b.x)], 1u);
            asm volatile("s_waitcnt vmcnt(0)" ::: "memory");
        } else {
            XB_SPIN(xb_ld(&bar[XB_XGEN(b.x)]) == gen, bar);
            __builtin_amdgcn_fence(__ATOMIC_ACQUIRE, "agent");
            asm volatile("s_waitcnt vmcnt(0)" ::: "memory");
        }
    }
    __syncthreads();
}

namespace pg8 {
constexpr int BM = 256, BK = 64, HALF = 128, HTB = HALF * BK * 2, STAGE_BYTES = 8 * HTB, NXCD = 8, WGM = 8;
__host__ __device__ __forceinline__ int lds_byte(int r, int c) { const int st = (r >> 4) * 2 + (c >> 5), rr = r & 15, cc = c & 31, ob = rr * 64 + cc * 2; return st * 1024 + (ob ^ (((ob >> 9) & 1) << 5)); }
__host__ __device__ __forceinline__ void stage_rc(int b, int& R, int& C) { const int st = b / 1024, sb = b % 1024, swz = sb ^ (((sb >> 9) & 1) << 5); R = (st >> 1) * 16 + swz / 64; C = (st & 1) * 32 + (swz % 64) / 2; }
__host__ __device__ __forceinline__ int perm32(int rho) { const int n = rho >> 4, i = rho & 15; return 8 * (i >> 2) + 4 * n + (i & 3); }
struct Unit { int pm, pn; };
struct Gemm { const bf16_t* A; const bf16_t* Bt; int M, N, K; };
struct StaticOrder {
    int nM, nN, nwg, G, c;
    __device__ void init(int M, int N, int G_, int c_) { nM = M / BM; nN = N / BM; nwg = nM * nN; G = G_; c = c_; }
    __device__ bool map(int L, Unit& u) const {
        int wgid = L; { const int q = nwg / NXCD, r = nwg % NXCD, xcd = wgid % NXCD, off = wgid / NXCD; wgid = (xcd < r ? xcd * (q + 1) : r * (q + 1) + (xcd - r) * q) + off; }
        const int nig = WGM * nN, gid = wgid / nig, fm = gid * WGM, gsz = (nM - fm) < WGM ? (nM - fm) : WGM;
        u.pm = fm + ((wgid % nig) % gsz); u.pn = (wgid % nig) / gsz; return true;
    }
    __device__ bool next(int i, Unit& u) const { const long L = (long)i * G + c; if (L >= nwg) return false; return map((int)L, u); }
};
struct InOrder : StaticOrder {
    __device__ bool next(int i, Unit& u) const {
        const long L = (long)i * G + c;
        if (L < nwg) return map((int)L, u);
        const int k = (int)(L - nwg); if (k >= 64) return false;
        u.pm = 128 + (k >> 3); u.pn = k & 7; return true;
    }
};

template <class Epi, class Sched>
__device__ __forceinline__ void gemm_phase(LAS unsigned char* lds, const Gemm g, const Sched& S, const Epi& E) {
    const int tid = threadIdx.x, wid = __builtin_amdgcn_readfirstlane(tid >> 6), lane = tid & 63, wr = wid >> 2, wc = wid & 3, fr = lane & 15, fq = lane >> 4;
    const int K = g.K, nt = K / BK;
    unsigned voffA[2], voffB[2];
#pragma unroll
    for (int i = 0; i < 2; ++i) { int R, C; stage_rc(tid * 16 + i * 8192, R, C); const int Rb = Epi::PERM ? ((R & ~31) + perm32(R & 31)) : R;
        voffA[i] = (unsigned)(R * K + C) * 2u; voffB[i] = (unsigned)(Rb * K + C) * 2u; }
    const size_t kstep = (size_t)(BK * 2);
    const size_t hstep = (size_t)HALF * K * 2;
    const size_t tstep = 2 * hstep;
    const unsigned ldsw = (unsigned)wid * 1024u;
    const int aoff = lds_byte(wr * 64 + fr, fq * 8), boff = lds_byte(wc * 32 + fr, fq * 8);
#define PG8_SA(b, h) (((b) * 2 + (h)) * HTB)
#define PG8_SB(b, h) ((4 + (b) * 2 + (h)) * HTB)
#define PG8_STAGE(bufoff, gbase, voff) do { _Pragma("unroll") for (int _i = 0; _i < 2; ++_i) \
        __builtin_amdgcn_global_load_lds((const unsigned*)((const char*)(gbase) + (voff)[_i]), (LAS unsigned*)(lds + (bufoff) + ldsw + _i * 8192), 16, 0, 0); } while (0)
#define PG8_LDA(dst, b, h) do { _Pragma("unroll") for (int m = 0; m < 4; ++m) _Pragma("unroll") for (int k = 0; k < 2; ++k) dst[m][k] = *(const LAS bf16x8*)(lds + PG8_SA(b, h) + aoff + m * 2048 + k * 1024); } while (0)
#define PG8_LDB(dst, b, h) do { _Pragma("unroll") for (int n = 0; n < 2; ++n) _Pragma("unroll") for (int k = 0; k < 2; ++k) dst[n][k] = *(const LAS bf16x8*)(lds + PG8_SB(b, h) + boff + n * 2048 + k * 1024); } while (0)
#define PG8_MMA(ai, bj, At, Bt) do { __builtin_amdgcn_s_setprio(1); _Pragma("unroll") for (int m = 0; m < 4; ++m) _Pragma("unroll") for (int n = 0; n < 2; ++n) _Pragma("unroll") for (int k = 0; k < 2; ++k) \
        acc[ai][bj][m][n] = __builtin_amdgcn_mfma_f32_16x16x32_bf16(Bt[n][k], At[m][k], acc[ai][bj][m][n], 0, 0, 0); __builtin_amdgcn_s_setprio(0); } while (0)
#define PG8_WAIT_V(n) asm volatile("s_waitcnt vmcnt(" #n ")" ::: "memory")
#define PG8_WAIT_L(n) asm volatile("s_waitcnt lgkmcnt(" #n ")" ::: "memory")
#define PG8_BAR __builtin_amdgcn_s_barrier()
#define PG8_SCHED __builtin_amdgcn_sched_barrier(0)
    Unit cur, nxt; int ui = 0;
    if (!S.next(0, cur)) return;
    f32x4 acc[2][2][4][2];
#pragma unroll
    for (int a = 0; a < 2; ++a)
#pragma unroll
        for (int b = 0; b < 2; ++b)
#pragma unroll
            for (int m = 0; m < 4; ++m)
#pragma unroll
                for (int n = 0; n < 2; ++n) acc[a][b][m][n] = (f32x4){0.f, 0.f, 0.f, 0.f};
    bf16x8 At[4][2], B0[2][2], B1[2][2];
    const char* cA = (const char*)g.A + (size_t)cur.pm * tstep; const char* cB = (const char*)g.Bt + (size_t)cur.pn * tstep;
    PG8_STAGE(PG8_SB(0, 0), cB, voffB); PG8_STAGE(PG8_SA(0, 0), cA, voffA); PG8_STAGE(PG8_SB(0, 1), cB + hstep, voffB); PG8_STAGE(PG8_SA(0, 1), cA + hstep, voffA);
    if (wr == 1) PG8_BAR;
    PG8_WAIT_V(4); PG8_BAR;
    PG8_STAGE(PG8_SB(1, 0), cB + kstep, voffB); PG8_STAGE(PG8_SA(1, 0), cA + kstep, voffA); PG8_STAGE(PG8_SB(1, 1), cB + hstep + kstep, voffB);
    PG8_WAIT_V(6); PG8_BAR;
    for (;;) {
        const bool has_next = S.next(ui + 1, nxt);
        const char* nA = has_next ? (const char*)g.A + (size_t)nxt.pm * tstep : cA; const char* nB = has_next ? (const char*)g.Bt + (size_t)nxt.pn * tstep : cB;
        for (int t = 0; t < nt; t += 2) {
            const bool last = (t == nt - 2);
            const char* a1 = cA + (size_t)(t + 1) * kstep;
            const char* a2 = last ? nA : cA + (size_t)(t + 2) * kstep; const char* b2 = last ? nB : cB + (size_t)(t + 2) * kstep;
            const char* a3 = a2 + kstep; const char* b3 = b2 + kstep;
            PG8_LDB(B0, 0, 0); PG8_SCHED; PG8_LDA(At, 0, 0); PG8_STAGE(PG8_SA(1, 1), a1 + hstep, voffA);
            PG8_WAIT_L(8); PG8_BAR; PG8_WAIT_L(0); PG8_MMA(0, 0, At, B0); PG8_BAR; PG8_SCHED;
            PG8_LDB(B1, 0, 1); PG8_STAGE(PG8_SB(0, 0), b2, voffB);
            PG8_BAR; PG8_WAIT_L(0); PG8_MMA(0, 1, At, B1); PG8_BAR;
            PG8_LDA(At, 0, 1); PG8_STAGE(PG8_SA(0, 0), a2, voffA);
            PG8_BAR; PG8_WAIT_L(0); PG8_MMA(1, 0, At, B0); PG8_BAR; PG8_SCHED;
            PG8_STAGE(PG8_SB(0, 1), b2 + hstep, voffB);
            PG8_WAIT_V(6); PG8_BAR; PG8_MMA(1, 1, At, B1); PG8_BAR;
            PG8_LDB(B0, 1, 0); PG8_SCHED; PG8_LDA(At, 1, 0); PG8_STAGE(PG8_SA(0, 1), a2 + hstep, voffA);
            PG8_WAIT_L(8); PG8_BAR; PG8_WAIT_L(0); PG8_MMA(0, 0, At, B0); PG8_BAR; PG8_SCHED;
            PG8_LDB(B1, 1, 1); PG8_STAGE(PG8_SB(1, 0), b3, voffB);
            PG8_BAR; PG8_WAIT_L(0); PG8_MMA(0, 1, At, B1); PG8_BAR;
            PG8_LDA(At, 1, 1); PG8_STAGE(PG8_SA(1, 0), a3, voffA);
            PG8_BAR; PG8_WAIT_L(0); PG8_MMA(1, 0, At, B0); PG8_BAR; PG8_SCHED;
            PG8_STAGE(PG8_SB(1, 1), b3 + hstep, voffB);
            PG8_WAIT_V(6); PG8_BAR; PG8_MMA(1, 1, At, B1); PG8_BAR;
        }
        if (wr == 0) PG8_BAR;
        E(acc, cur, wr, wc, fr, fq);
        if (wr == 1) PG8_BAR;
        if (!has_next) break;
#pragma unroll
        for (int a = 0; a < 2; ++a)
#pragma unroll
            for (int b = 0; b < 2; ++b)
#pragma unroll
                for (int m = 0; m < 4; ++m)
#pragma unroll
                    for (int n = 0; n < 2; ++n) acc[a][b][m][n] = (f32x4){0.f, 0.f, 0.f, 0.f};
        cur = nxt; cA = nA; cB = nB; ++ui;
    }
    PG8_WAIT_V(0);
    if (wr == 0) PG8_BAR;
    PG8_BAR;
#undef PG8_SA
#undef PG8_SB
#undef PG8_STAGE
#undef PG8_LDA
#undef PG8_LDB
#undef PG8_MMA
#undef PG8_WAIT_V
#undef PG8_WAIT_L
#undef PG8_BAR
#undef PG8_SCHED
}
}

template <int K> __device__ __forceinline__ float dpp_shr(float x) { return __int_as_float(__builtin_amdgcn_update_dpp(0, __float_as_int(x), 0x110 + K, 0xf, 0xf, true)); }
__device__ __forceinline__ float scan16(float x) { x += dpp_shr<1>(x); x += dpp_shr<2>(x); x += dpp_shr<4>(x); x += dpp_shr<8>(x); return x; }
__device__ __forceinline__ float clamp80(float x) { return fminf(fmaxf(x, -80.f), 80.f); }
struct EpiIn {
    static constexpr bool PERM = true;
    unsigned char* ws; const float* lb_logits;
    __device__ __forceinline__ void operator()(const f32x4 (&acc)[2][2][4][2], const pg8::Unit& u, int wr, int wc, int fr, int fq) const {
        asm volatile("s_nop 15\n\ts_nop 15\n\ts_nop 15\n\ts_nop 15" ::: "memory");
        const int row0 = u.pm * 256 + wr * 64 + fr, pn = u.pn;
        if (pn < 8) {
            bf16_t* QF = (bf16_t*)(ws + WS_QF); bf16_t* QB = (bf16_t*)(ws + WS_QB); bf16_t* KF = (bf16_t*)(ws + WS_KF); bf16_t* KB = (bf16_t*)(ws + WS_KB); bf16_t* V = (bf16_t*)(ws + WS_V);
            float* RT = (float*)(ws + WS_RT);
            const int ch0 = 64 * pn + 16 * wc + 4 * fq;
            float lbF[4], lbB[4];
#pragma unroll
            for (int j = 0; j < 4; ++j) { lbF[j] = 1.f / (1.f + __expf(lb_logits[1024 + ch0 + j] - lb_logits[ch0 + j])); lbB[j] = 1.f / (1.f + __expf(lb_logits[1536 + ch0 + j] - lb_logits[512 + ch0 + j])); }
#pragma unroll
            for (int ai = 0; ai < 2; ++ai) {
                const int rowc = u.pm * 256 + 128 * ai + 64 * wr;
                const int cid = rowc >> 6;
                unsigned oQF[4][2], oQB[4][2], oKF[4][2], oKB[4][2]; f32x4 rtv[4];
#pragma unroll
                for (int jp = 0; jp < 2; ++jp) {
                    float vQF[4][2], vQB[4][2], vKF[4][2], vKB[4][2];
#pragma unroll
                    for (int jj = 0; jj < 2; ++jj) {
                        const int j = 2 * jp + jj;
                        float lfF[4], kkF[4], lfB[4], kkB[4], pF[4], pB[4], tF[4], tB[4];
#pragma unroll
                        for (int m = 0; m < 4; ++m) {
                            { const float z = acc[ai][0][m][1][j]; const float e = __expf(fminf(-z, 30.f)); const float s = __builtin_amdgcn_rcpf(1.f + e); lfF[m] = __logf(lbF[j] + (1.f - lbF[j]) * s); kkF[m] = (1.f - lbF[j]) * e * s; }
                            { const float z = acc[ai][1][m][0][j]; const float e = __expf(fminf(-z, 30.f)); const float s = __builtin_amdgcn_rcpf(1.f + e); lfB[m] = __logf(lbB[j] + (1.f - lbB[j]) * s); kkB[m] = (1.f - lbB[j]) * e * s; }
                            pF[m] = scan16(lfF[m]); pB[m] = scan16(lfB[m]);
                            tF[m] = __int_as_float(__builtin_amdgcn_update_dpp(0, __float_as_int(pF[m]), 0x15F, 0xf, 0xf, true));
                            tB[m] = __int_as_float(__builtin_amdgcn_update_dpp(0, __float_as_int(pB[m]), 0x15F, 0xf, 0xf, true));
                        }
                        const float rF = tF[0] + tF[1], blF = rF + tF[2] + tF[3];
                        const float rB = tB[2] + tB[3], blB = rB + tB[0] + tB[1];
                        float cF = 0.f, cB = 0.f;
#pragma unroll
                        for (int m = 0; m < 4; ++m) {
                            const float bF = pF[m] + cF; cF += tF[m];
                            const float bB = blB - (pB[m] + cB) + lfB[m]; cB += tB[m];
                            const float xF = clamp80(bF - rF), xB = clamp80(bB - rB);
                            const float q = acc[ai][0][m][0][j];
                            vQF[m][jj] = q * __expf(xF); vKF[m][jj] = kkF[m] * __expf(-xF);
                            vQB[m][jj] = q * __expf(xB); vKB[m][jj] = kkB[m] * __expf(-xB);
                        }
                        rtv[0][j] = rF; rtv[1][j] = rB; rtv[2][j] = blF - rF; rtv[3][j] = blB - rB;
                    }
#pragma unroll
                    for (int m = 0; m < 4; ++m) { oQF[m][jp] = cvt_pk_bf16(vQF[m][0], vQF[m][1]); oQB[m][jp] = cvt_pk_bf16(vQB[m][0], vQB[m][1]); oKF[m][jp] = cvt_pk_bf16(vKF[m][0], vKF[m][1]); oKB[m][jp] = cvt_pk_bf16(vKB[m][0], vKB[m][1]); }
                }
                if (fr == 0) {
#pragma unroll
                    for (int t = 0; t < 4; ++t) *(f32x4*)(RT + (size_t)t * NCHUNK * 512 + (size_t)cid * 512 + ch0) = rtv[t];
                }
#pragma unroll
                for (int mp = 0; mp < 2; ++mp) {
                    const int a = 2 * mp, bb = 2 * mp + 1, odd = fq & 1;
                    const size_t off = (size_t)(rowc + 16 * (odd ? bb : a) + fr) * 512 + (ch0 - 4 * odd);
                    const f32x4 va = acc[ai][1][a][1], vb = acc[ai][1][bb][1];
                    const unsigned oVa0 = cvt_pk_bf16(va[0], va[1]), oVa1 = cvt_pk_bf16(va[2], va[3]), oVb0 = cvt_pk_bf16(vb[0], vb[1]), oVb1 = cvt_pk_bf16(vb[2], vb[3]);
                    asm volatile("s_nop 1" ::: "memory");
#define WIDE_ST(P, x0a, x1a, x0b, x1b) do { const u32x2 s0 = __builtin_amdgcn_permlane16_swap((x0a), (x0b), false, false), s1 = __builtin_amdgcn_permlane16_swap((x1a), (x1b), false, false); \
                        *(u32x4*)((P) + off) = (u32x4){s0[0], s1[0], s0[1], s1[1]}; } while (0)
                    WIDE_ST(QF, oQF[a][0], oQF[a][1], oQF[bb][0], oQF[bb][1]); WIDE_ST(QB, oQB[a][0], oQB[a][1], oQB[bb][0], oQB[bb][1]);
                    WIDE_ST(KF, oKF[a][0], oKF[a][1], oKF[bb][0], oKF[bb][1]); WIDE_ST(KB, oKB[a][0], oKB[a][1], oKB[bb][0], oKB[bb][1]);
                    WIDE_ST(V, oVa0, oVa1, oVb0, oVb1);
#undef WIDE_ST
                }
            }
        } else if (pn >= 10 && pn <= 13) {
            bf16_t* G = (bf16_t*)(ws + WS_G);
            const int chb = 128 * (pn - 10) + 16 * wc + 4 * fq;
            const int odd = fq & 1;
#pragma unroll
            for (int ai = 0; ai < 2; ++ai)
#pragma unroll
                for (int mp = 0; mp < 2; ++mp) {
                    const size_t row = (size_t)(row0 + ai * 128 + (2 * mp + odd) * 16);
#pragma unroll
                    for (int bj = 0; bj < 2; ++bj) {
                        const f32x4 ua = acc[ai][bj][2 * mp][0], ga = acc[ai][bj][2 * mp][1], ub = acc[ai][bj][2 * mp + 1][0], gb = acc[ai][bj][2 * mp + 1][1];
                        const unsigned a0 = cvt_pk_bf16(ua[0] * sigmoidf_(ga[0]), ua[1] * sigmoidf_(ga[1])), a1 = cvt_pk_bf16(ua[2] * sigmoidf_(ga[2]), ua[3] * sigmoidf_(ga[3]));
                        const unsigned b0 = cvt_pk_bf16(ub[0] * sigmoidf_(gb[0]), ub[1] * sigmoidf_(gb[1])), b1 = cvt_pk_bf16(ub[2] * sigmoidf_(gb[2]), ub[3] * sigmoidf_(gb[3]));
                        asm volatile("s_nop 1" ::: "memory");
                        const u32x2 s0 = __builtin_amdgcn_permlane16_swap(a0, b0, false, false), s1 = __builtin_amdgcn_permlane16_swap(a1, b1, false, false);
                        *(u32x4*)(G + row * 512 + (chb - 4 * odd) + 64 * bj) = (u32x4){s0[0], s1[0], s0[1], s1[1]};
                    }
                }
        } else {
            bf16_t* D = (bf16_t*)(ws + (pn < 10 ? WS_GA : WS_GB));
            const int colb = 256 * (pn < 10 ? pn - 8 : pn - 14) + 32 * wc + 8 * fq;
#pragma unroll
            for (int ai = 0; ai < 2; ++ai)
#pragma unroll
                for (int m = 0; m < 4; ++m) {
                    const size_t row = (size_t)(row0 + ai * 128 + m * 16);
#pragma unroll
                    for (int bj = 0; bj < 2; ++bj) {
                        f32x4 v0 = acc[ai][bj][m][0], v1 = acc[ai][bj][m][1];
#pragma unroll
                        for (int j = 0; j < 4; ++j) { v0[j] = siluf_(v0[j]); v1[j] = siluf_(v1[j]); }
                        u32x4 o = {cvt_pk_bf16(v0[0], v0[1]), cvt_pk_bf16(v0[2], v0[3]), cvt_pk_bf16(v1[0], v1[1]), cvt_pk_bf16(v1[2], v1[3])};
                        *(u32x4*)(D + row * 512 + colb + 128 * bj) = o;
                    }
                }
        }
    }
};

struct EpiOut {
    static constexpr bool PERM = true;
    bf16_t* Y;
    __device__ __forceinline__ void operator()(const f32x4 (&acc)[2][2][4][2], const pg8::Unit& u, int wr, int wc, int fr, int fq) const {
        asm volatile("s_nop 15\n\ts_nop 15\n\ts_nop 15\n\ts_nop 15" ::: "memory");
        const int row0 = u.pm * 256 + wr * 64 + fr, col0 = u.pn * 256 + wc * 32 + 8 * fq;
#pragma unroll
        for (int ai = 0; ai < 2; ++ai)
#pragma unroll
            for (int m = 0; m < 4; ++m) {
                const size_t row = (size_t)(row0 + ai * 128 + m * 16);
#pragma unroll
                for (int bj = 0; bj < 2; ++bj) {
                    const f32x4 v0 = acc[ai][bj][m][0], v1 = acc[ai][bj][m][1];
                    u32x4 o = {cvt_pk_bf16(v0[0], v0[1]), cvt_pk_bf16(v0[2], v0[3]), cvt_pk_bf16(v1[0], v1[1]), cvt_pk_bf16(v1[2], v1[3])};
                    *(u32x4*)(Y + row * 1024 + col0 + 128 * bj) = o;
                }
            }
    }
};

__device__ void phase0(LAS unsigned char* lds, const Params& p, int it_lo, int it_hi) {
    const int tid = threadIdx.x;
    LAS float* fl = (LAS float*)lds;
    float* modp = (float*)(p.ws + WS_MODP);
    for (int it = it_lo + blockIdx.x; it < it_hi; it += gridDim.x) {
        if (it < 192) {
            const int cc = it % 48, kq = it / 48;
            LAS float* sil = fl; LAS float* red = fl + 2304;
            for (int i = tid; i < 2304; i += NTHR) { const int j = i >> 8, k = kq * 256 + (i & 255); const float v = (j < 8) ? p.c[j * 1024 + k] : p.c_ctx[k]; sil[i] = siluf_(v); }
            __syncthreads();
            const int n = tid & 63, ks = tid >> 6;
            const float* wp = p.w_mod + (size_t)(kq * 256 + ks * 32) * 3072 + cc * 64 + n;
            float a[9];
#pragma unroll
            for (int j = 0; j < 9; ++j) a[j] = 0.f;
#pragma unroll 8
            for (int kk = 0; kk < 32; ++kk) { const float w = wp[(size_t)kk * 3072];
#pragma unroll
                for (int j = 0; j < 9; ++j) a[j] += sil[j * 256 + ks * 32 + kk] * w; }
#pragma unroll
            for (int j = 0; j < 9; ++j) red[(ks * 9 + j) * 64 + n] = a[j];
            __syncthreads();
            for (int i = tid; i < 576; i += NTHR) { const int j = i >> 6, nn = i & 63; float s = 0.f;
#pragma unroll
                for (int k2 = 0; k2 < 8; ++k2) s += red[(k2 * 9 + j) * 64 + nn];
                modp[(kq * 9 + j) * 3072 + cc * 64 + nn] = s; }
            __syncthreads();
        } else {
            int t = it - 192; const float* W; bf16_t* WT; int N; bool isin;
            if (t < 1024) { W = p.w_in; WT = (bf16_t*)(p.ws + WS_WIN); N = 4096; isin = true; } else { t -= 1024; W = p.w_out; WT = (bf16_t*)(p.ws + WS_WOUT); N = 1024; isin = false; }
            const int kt = t & 15, nt = t >> 4;
            const int n = tid & 63, k0 = tid >> 6;
            const int ncol = nt * 64 + n; int src = ncol;
            if (isin && ncol < 2048) { const int pnn = ncol >> 8, cc = ncol & 255; const int type = ((cc >> 7) << 1) | ((cc >> 2) & 1); src = type * 512 + 64 * pnn + 16 * ((cc >> 5) & 3) + 4 * ((cc >> 3) & 3) + (cc & 3); }
            else if (isin && ncol >= 2560 && ncol < 3584) { const int mm = ncol - 2560, g = mm >> 3, i = mm & 7; src = (i < 4) ? 2560 + 4 * g + i : 3072 + 4 * g + (i - 4); }
#pragma unroll
            for (int ps = 0; ps < 8; ++ps) { const int k = ps * 8 + k0; fl[k * 65 + n] = W[(size_t)(kt * 64 + k) * N + src]; }
            __syncthreads();
            const int nn = tid >> 3, k8 = tid & 7;
            float v[8];
#pragma unroll
            for (int j = 0; j < 8; ++j) v[j] = fl[(k8 * 8 + j) * 65 + nn];
            u32x4 o = {cvt_pk_bf16(v[0], v[1]), cvt_pk_bf16(v[2], v[3]), cvt_pk_bf16(v[4], v[5]), cvt_pk_bf16(v[6], v[7])};
            *(u32x4*)(WT + (size_t)(nt * 64 + nn) * 1024 + kt * 64 + k8 * 8) = o;
            __syncthreads();
        }
    }
}

__device__ void phase1(LAS unsigned char* lds, const Params& p) {
    const int tid = threadIdx.x, w = tid >> 6, lane = tid & 63;
    LAS float* mv = (LAS float*)lds;
    const float* modp = (const float*)(p.ws + WS_MODP);
    bf16_t* A = (bf16_t*)(p.ws + WS_A);
    const int ngrp = NROWS / 8;
    const int g0 = (int)((long)blockIdx.x * ngrp / gridDim.x), g1 = (int)((long)(blockIdx.x + 1) * ngrp / gridDim.x);
    int curj = -1;
    for (int g = g0; g < g1; ++g) {
        const int row0 = g * 8; const int j = row0 < NLAT ? (row0 >> 12) : 8;
        if (j != curj) {
            __syncthreads();
            for (int i = tid; i < 1024; i += NTHR) { float sh = p.b_mod[i], sc = p.b_mod[1024 + i];
#pragma unroll
                for (int q = 0; q < 4; ++q) { sh += modp[(q * 9 + j) * 3072 + i]; sc += modp[(q * 9 + j) * 3072 + 1024 + i]; }
                mv[i] = p.norm_g[i] * (1.f + sc); mv[1024 + i] = sh; }
            __syncthreads(); curj = j;
        }
        const int row = row0 + w;
        const float* xr = row < NLAT ? p.x + (size_t)row * 1024 : p.ctx + (size_t)(row - NLAT) * 1024;
        f32x4 v[4]; float ss = 0.f;
#pragma unroll
        for (int c = 0; c < 4; ++c) { v[c] = *(const f32x4*)(xr + c * 256 + lane * 4); ss += v[c][0] * v[c][0] + v[c][1] * v[c][1] + v[c][2] * v[c][2] + v[c][3] * v[c][3]; }
#pragma unroll
        for (int m = 32; m >= 1; m >>= 1) ss += __shfl_xor(ss, m);
        const float rs = rsqrtf(ss * (1.f / 1024.f) + EPS);
#pragma unroll
        for (int c = 0; c < 4; ++c) { const int k = c * 256 + lane * 4; const f32x4 m0 = *(const LAS f32x4*)(mv + k), m1 = *(const LAS f32x4*)(mv + 1024 + k);
            const f32x4 a = v[c] * rs * m0 + m1; u32x2 o = {cvt_pk_bf16(a[0], a[1]), cvt_pk_bf16(a[2], a[3])}; *(u32x2*)(A + (size_t)row * 1024 + k) = o; }
    }
}

#define MFMA16(a, b, c) __builtin_amdgcn_mfma_f32_16x16x32_bf16((a), (b), (c), 0, 0, 0)
__device__ __forceinline__ int scan_cid(int n, int dir, int b) { return n < 4 ? 512 + b * 4 + (dir ? 3 - n : n) : b * 64 + (dir ? 67 - n : n - 4); }
#define SCAN_BAR() asm volatile("s_waitcnt lgkmcnt(0)\n\ts_barrier" ::: "memory")
#define SB_() __builtin_amdgcn_sched_barrier(0)
typedef short s16x4 __attribute__((ext_vector_type(4)));
__device__ __forceinline__ bf16x8 tr_pair(const LAS bf16_t* img, int stride, int r0a, int r0b, int c0, int ln) {
    const int q = ln >> 2, p = ln & 3;
    const s16x4 a = __builtin_amdgcn_ds_read_tr16_b64_v4i16((LAS s16x4*)(img + (r0a + q) * stride + c0 + 4 * p));
    const s16x4 b = __builtin_amdgcn_ds_read_tr16_b64_v4i16((LAS s16x4*)(img + (r0b + q) * stride + c0 + 4 * p));
    return __builtin_shufflevector(a, b, 0, 1, 2, 3, 4, 5, 6, 7);
}
__device__ void scan_phase(LAS unsigned char* lds, const Params& p) {
    const int tid = threadIdx.x, w = __builtin_amdgcn_readfirstlane(tid >> 6), lane = tid & 63, ln = lane & 15, lq = lane >> 4;
    constexpr int QST = 136, VST = 36;
    constexpr int OFF_KS = 17408, OFF_V = 34816, BUFB = 39424;
    LAS bf16_t* Sr = (LAS bf16_t*)(lds + 2 * BUFB);
    LAS float* scs = (LAS float*)(lds + 2 * BUFB + 9216);
    bf16_t* O = (bf16_t*)p.out;
    bf16_t* Odummy = (bf16_t*)(p.ws + WS_A) + (size_t)blockIdx.x * 64 * 512;
    const float* RT = (const float*)(p.ws + WS_RT);
    const int eb = w & 1, tb = w >> 1;
    if (w >= 4) __builtin_amdgcn_s_setprio(1);
    for (int item = blockIdx.x; item < 256; item += gridDim.x) {
        const int seq = (item & 7) + 8 * (item >> 5), es = (item >> 3) & 3;
        const int dir = seq & 1, h = (seq >> 1) & 3, b = seq >> 3;
        const char* Qx = (const char*)((const bf16_t*)(p.ws + (dir ? WS_QB : WS_QF)) + h * 128);
        const char* Kx = (const char*)((const bf16_t*)(p.ws + (dir ? WS_KB : WS_KF)) + h * 128);
        const char* Vx = (const char*)((const bf16_t*)(p.ws + WS_V) + h * 128 + es * 32);
        const char* Rx = (const char*)(RT + (size_t)dir * NCHUNK * 512 + h * 128);
        const char* Tx = (const char*)(RT + (size_t)(2 + dir) * NCHUNK * 512 + h * 128);
        const unsigned qoff0 = (unsigned)((dir ? 63 - (tid >> 4) : (tid >> 4)) * 1024 + (tid & 15) * 16), qstep = dir ? (unsigned)-32768 : 32768u;
        const unsigned voff = (unsigned)((dir ? 63 - (tid >> 3) : (tid >> 3)) * 1024 + (tid & 7) * 8), roff = (unsigned)(tid & 127) * 4u;
        f32x4 S[2] = {(f32x4){0.f, 0.f, 0.f, 0.f}, (f32x4){0.f, 0.f, 0.f, 0.f}};
        float tailp = 0.f;
        u32x4 k4A[2], k4B[2], k4C[2], k4D[2]; u32x4 q4A[2], q4B[2], q4C[2], q4D[2]; u32x2 v4A, v4B, v4C, v4D; float rvA, tlA, rvB, tlB, rvC, tlC, rvD, tlD;
#define SCAN_LOAD(n, k4, q4, v4, rv, tl) do { const size_t cb_ = (size_t)scan_cid((n), dir, b) * 65536; const size_t rb_ = (size_t)scan_cid((n), dir, b) * 2048; SB_(); \
            _Pragma("unroll") for (int i = 0; i < 2; ++i) { k4[i] = *(const u32x4*)(Kx + cb_ + (qoff0 + (unsigned)i * qstep)); SB_(); } \
            _Pragma("unroll") for (int i = 0; i < 2; ++i) { q4[i] = *(const u32x4*)(Qx + cb_ + (qoff0 + (unsigned)i * qstep)); SB_(); } \
            v4 = *(const u32x2*)(Vx + cb_ + voff); SB_(); rv = *(const float*)(Rx + rb_ + roff); SB_(); tl = *(const float*)(Tx + rb_ + roff); SB_(); } while (0)
#define SCAN_STAGE(bf, k4, q4, v4, rv, tl) do { LAS unsigned char* B_ = lds + (bf) * BUFB; \
            _Pragma("unroll") for (int i = 0; i < 2; ++i) { const int pc = tid + 512 * i; *(LAS u32x4*)(B_ + ((pc >> 4) * QST + (pc & 15) * 8) * 2) = q4[i]; *(LAS u32x4*)(B_ + OFF_KS + ((pc >> 4) * QST + (pc & 15) * 8) * 2) = k4[i]; } \
            *(LAS u32x2*)(B_ + OFF_V + ((tid >> 3) * VST + (tid & 7) * 4) * 2) = v4; \
            if (tid < 128) { scs[(bf) * 128 + tid] = __expf(rv + tailp); tailp = tl; } } while (0)
#define SCAN_MAT(bf, n) do { LAS unsigned char* B_ = lds + (bf) * BUFB; LAS bf16_t* Qs = (LAS bf16_t*)B_; LAS bf16_t* Ks = (LAS bf16_t*)(B_ + OFF_KS); LAS bf16_t* Vs = (LAS bf16_t*)(B_ + OFF_V); \
            _Pragma("unroll") for (int ti = 0; ti < 2; ++ti) { const int db = 2 * tb + ti; const float scv = scs[(bf) * 128 + 16 * db + ln]; S[ti] *= scv; \
                *(LAS u32x2*)(Sr + (16 * db + ln) * VST + 16 * eb + 4 * lq) = (u32x2){cvt_pk_bf16(S[ti][0], S[ti][1]), cvt_pk_bf16(S[ti][2], S[ti][3])}; } \
            bf16x8 Bq[4]; f32x4 pt[4]; \
            _Pragma("unroll") for (int ks = 0; ks < 4; ++ks) Bq[ks] = *(const LAS bf16x8*)(Qs + (16 * tb + ln) * QST + ks * 32 + lq * 8); \
            _Pragma("unroll") for (int sb = 0; sb < 4; ++sb) { pt[sb] = (f32x4){0.f, 0.f, 0.f, 0.f}; \
                if (sb <= tb) { f32x4 a = (f32x4){0.f, 0.f, 0.f, 0.f}; \
                    _Pragma("unroll") for (int ks = 0; ks < 4; ++ks) { const bf16x8 Ak = *(const LAS bf16x8*)(Ks + (16 * sb + ln) * QST + ks * 32 + lq * 8); a = MFMA16(Ak, Bq[ks], a); } \
                    if (sb == tb) { _Pragma("unroll") for (int i = 0; i < 4; ++i) if (4 * lq + i > ln) a[i] = 0.f; } \
                    pt[sb] = a; } } \
            SCAN_BAR(); \
            f32x4 o = (f32x4){0.f, 0.f, 0.f, 0.f}; \
            _Pragma("unroll") for (int ks = 0; ks < 4; ++ks) { const bf16x8 As = tr_pair(Sr, VST, 32 * ks + 8 * lq, 32 * ks + 8 * lq + 4, 16 * eb, ln); o = MFMA16(As, Bq[ks], o); } \
            _Pragma("unroll") for (int g = 0; g < 2; ++g) { if (2 * g <= tb) { \
                    const bf16x8 Av = tr_pair(Vs, VST, 32 * g + 4 * lq, 32 * g + 16 + 4 * lq, 16 * eb, ln); \
                    const u32x4 bp = {cvt_pk_bf16_mfma(pt[2 * g][0], pt[2 * g][1]), cvt_pk_bf16(pt[2 * g][2], pt[2 * g][3]), cvt_pk_bf16(pt[2 * g + 1][0], pt[2 * g + 1][1]), cvt_pk_bf16(pt[2 * g + 1][2], pt[2 * g + 1][3])}; \
                    o = MFMA16(Av, __builtin_bit_cast(bf16x8, bp), o); } } \
            { const int pos = 16 * tb + ln; const size_t row = (size_t)scan_cid((n), dir, b) * 64 + (dir ? 63 - pos : pos); \
              bf16_t* dst = ((n) >= 4) ? O + ((size_t)dir * NLAT + row) * 512 + h * 128 + es * 32 : Odummy + (size_t)pos * 512;     \
              *(u32x2*)(dst + 16 * eb + 4 * lq) = (u32x2){cvt_pk_bf16_mfma(o[0], o[1]), cvt_pk_bf16_mfma(o[2], o[3])}; } \
            _Pragma("unroll") for (int k2i = 0; k2i < 2; ++k2i) { const bf16x8 Av = tr_pair(Vs, VST, 32 * k2i + 8 * lq, 32 * k2i + 8 * lq + 4, 16 * eb, ln); \
                _Pragma("unroll") for (int ti = 0; ti < 2; ++ti) { const bf16x8 Bk = tr_pair(Ks, QST, 32 * k2i + 8 * lq, 32 * k2i + 8 * lq + 4, 16 * (2 * tb + ti), ln); S[ti] = MFMA16(Av, Bk, S[ti]); } } \
            } while (0)
        SCAN_LOAD(0, k4A, q4A, v4A, rvA, tlA); SCAN_LOAD(1, k4B, q4B, v4B, rvB, tlB); SCAN_LOAD(2, k4C, q4C, v4C, rvC, tlC); SCAN_LOAD(3, k4D, q4D, v4D, rvD, tlD);
        SCAN_STAGE(0, k4A, q4A, v4A, rvA, tlA); SCAN_LOAD(4, k4A, q4A, v4A, rvA, tlA);
        SCAN_BAR();
#pragma unroll 1
        for (int n0 = 0; n0 < 68; n0 += 4) {
            SCAN_STAGE(1, k4B, q4B, v4B, rvB, tlB); SCAN_LOAD(min(n0 + 5, 67), k4B, q4B, v4B, rvB, tlB); SCAN_MAT(0, n0); SCAN_BAR();
            SCAN_STAGE(0, k4C, q4C, v4C, rvC, tlC); SCAN_LOAD(min(n0 + 6, 67), k4C, q4C, v4C, rvC, tlC); SCAN_MAT(1, n0 + 1); SCAN_BAR();
            SCAN_STAGE(1, k4D, q4D, v4D, rvD, tlD); SCAN_LOAD(min(n0 + 7, 67), k4D, q4D, v4D, rvD, tlD); SCAN_MAT(0, n0 + 2); SCAN_BAR();
            SCAN_STAGE(0, k4A, q4A, v4A, rvA, tlA); SCAN_LOAD(min(n0 + 8, 67), k4A, q4A, v4A, rvA, tlA); SCAN_MAT(1, n0 + 3); SCAN_BAR();
        }
#undef SCAN_LOAD
#undef SCAN_STAGE
#undef SCAN_MAT
    }
    __builtin_amdgcn_s_setprio(0);
}

__device__ void conv_phase(LAS unsigned char* lds, const Params& p) {
    const int tid = threadIdx.x, w = tid >> 6, lane = tid & 63;
    LAS float* wl = (LAS float*)lds;
    for (int i = tid; i < 32 * 128; i += NTHR) ((LAS f32x4*)wl)[i] = (i < 31 * 128) ? ((const f32x4*)p.conv_w)[i] : (f32x4){0.f, 0.f, 0.f, 0.f};
    __syncthreads();
    const bf16_t* Gp = (const bf16_t*)(p.ws + WS_G); const bf16_t* GAp = (const bf16_t*)(p.ws + WS_GA); const bf16_t* GBp = (const bf16_t*)(p.ws + WS_GB);
    const bf16_t* O = (const bf16_t*)p.out;
    bf16_t* A2 = (bf16_t*)(p.ws + WS_A);
    const int half = lane >> 5, ch0 = lane * 8;
    for (int it = blockIdx.x * 8 + w; it < 8192; it += gridDim.x * 8) {
        const int b = it >> 10, r0 = ((it >> 5) & 31) * 2, c0 = (it & 31) * 2;
        float acc[4][8];
        const char* Pb = (const char*)Gp;
        const int base = half ? r0 : c0;
        const unsigned stepB = (half ? 64u : 1u) * 1024u;
#pragma unroll 1
        for (int line = 0; line < 2; ++line) {
            const int tok0 = half ? (c0 + line) : (r0 + line) * 64;
            const unsigned offb = (unsigned)((b * 4096 + tok0) * 512 + ch0) * 2u;
            asm volatile("" ::: "memory");
            float cur[2][8];
#pragma unroll
            for (int a = 0; a < 2; ++a)
#pragma unroll
                for (int c = 0; c < 8; ++c) cur[a][c] = 0.f;
            float Wp[8];
#pragma unroll
            for (int c = 0; c < 8; ++c) Wp[c] = 0.f;
#pragma unroll 1
            for (int hb = 0; hb < 4; ++hb) {
                u32x4 raw[8];
#pragma unroll
                for (int q = 0; q < 8; ++q) {
                    const int xx = base - 15 + hb * 8 + q;
                    const int xc = min(max(xx, 0), 63);
                    const u32x4 r = *(const u32x4*)(Pb + (offb + (unsigned)xc * stepB));
                    const bool ok = (xx == xc);
                    raw[q] = (u32x4){ok ? r[0] : 0u, ok ? r[1] : 0u, ok ? r[2] : 0u, ok ? r[3] : 0u};
                }
                const LAS float* wrow = wl + hb * 8 * 512 + ch0;
#pragma unroll
                for (int q = 0; q < 8; ++q) {
                    const float in[8] = {bf_lo(raw[q][0]), bf_hi(raw[q][0]), bf_lo(raw[q][1]), bf_hi(raw[q][1]), bf_lo(raw[q][2]), bf_hi(raw[q][2]), bf_lo(raw[q][3]), bf_hi(raw[q][3])};
                    const f32x4 wa = *(const LAS f32x4*)(wrow + q * 512), wb = *(const LAS f32x4*)(wrow + q * 512 + 4);
                    const float Wc[8] = {wa[0], wa[1], wa[2], wa[3], wb[0], wb[1], wb[2], wb[3]};
#pragma unroll
                    for (int c = 0; c < 8; ++c) { cur[0][c] += Wc[c] * in[c]; cur[1][c] += Wp[c] * in[c]; Wp[c] = Wc[c]; }
                }
            }
#pragma unroll
            for (int j = 0; j < 2; ++j)
#pragma unroll
                for (int c = 0; c < 8; ++c) { if (line == 0) acc[j][c] = cur[j][c]; else acc[2 + j][c] = cur[j][c]; }
        }
        float cbv[8], lg[8], lbv[8], hg[8];
        { const f32x4 a0 = *(const f32x4*)(p.conv_b + ch0), a1 = *(const f32x4*)(p.conv_b + ch0 + 4), b0 = *(const f32x4*)(p.conv_ln_g + ch0), b1 = *(const f32x4*)(p.conv_ln_g + ch0 + 4);
          const f32x4 d0 = *(const f32x4*)(p.conv_ln_b + ch0), d1 = *(const f32x4*)(p.conv_ln_b + ch0 + 4), e0 = *(const f32x4*)(p.hgrn_norm_g + ch0), e1 = *(const f32x4*)(p.hgrn_norm_g + ch0 + 4);
#pragma unroll
          for (int c = 0; c < 4; ++c) { cbv[c] = a0[c]; cbv[4 + c] = a1[c]; lg[c] = b0[c]; lg[4 + c] = b1[c]; lbv[c] = d0[c]; lbv[4 + c] = d1[c]; hg[c] = e0[c]; hg[4 + c] = e1[c]; } }
#pragma unroll
        for (int lr = 0; lr < 2; ++lr)
#pragma unroll
            for (int lc = 0; lc < 2; ++lc) {
                const size_t token = (size_t)b * 4096 + (r0 + lr) * 64 + (c0 + lc);
                float v[8]; float s1 = 0.f, s2 = 0.f;
#pragma unroll
                for (int c = 0; c < 8; ++c) { v[c] = (half ? acc[lc * 2 + lr][c] : acc[lr * 2 + lc][c]) + cbv[c]; s1 += v[c]; s2 += v[c] * v[c]; }
#pragma unroll
                for (int m = 32; m >= 1; m >>= 1) { s1 += __shfl_xor(s1, m); s2 += __shfl_xor(s2, m); }
                const float mean = s1 * (1.f / 512.f), var = fmaxf(s2 * (1.f / 512.f) - mean * mean, 0.f), rstd = rsqrtf(var + EPS);
                const u32x4 gbr = *(const u32x4*)(GBp + token * 512 + ch0);
                const float gbv[8] = {bf_lo(gbr[0]), bf_hi(gbr[0]), bf_lo(gbr[1]), bf_hi(gbr[1]), bf_lo(gbr[2]), bf_hi(gbr[2]), bf_lo(gbr[3]), bf_hi(gbr[3])};
                float y[8];
#pragma unroll
                for (int c = 0; c < 8; ++c) { const float t = (v[c] - mean) * rstd * lg[c] + lbv[c]; y[c] = siluf_(t) * gbv[c]; }
                u32x4 ob = {cvt_pk_bf16(y[0], y[1]), cvt_pk_bf16(y[2], y[3]), cvt_pk_bf16(y[4], y[5]), cvt_pk_bf16(y[6], y[7])};
                *(u32x4*)(A2 + token * 1024 + 512 + ch0) = ob;
                const u32x4 fo = *(const u32x4*)(O + token * 512 + ch0), bo = *(const u32x4*)(O + ((size_t)NLAT + token) * 512 + ch0);
                float ov[8]; float ss = 0.f;
#pragma unroll
                for (int c = 0; c < 4; ++c) { ov[2 * c] = bf_lo(fo[c]) + bf_lo(bo[c]); ov[2 * c + 1] = bf_hi(fo[c]) + bf_hi(bo[c]); }
#pragma unroll
                for (int c = 0; c < 8; ++c) ss += ov[c] * ov[c];
                ss += __shfl_xor(ss, 1); ss += __shfl_xor(ss, 2); ss += __shfl_xor(ss, 4); ss += __shfl_xor(ss, 8);
                const float rn = rsqrtf(ss * (1.f / 128.f) + EPS);
                const u32x4 gar = *(const u32x4*)(GAp + token * 512 + ch0);
                const float gav[8] = {bf_lo(gar[0]), bf_hi(gar[0]), bf_lo(gar[1]), bf_hi(gar[1]), bf_lo(gar[2]), bf_hi(gar[2]), bf_lo(gar[3]), bf_hi(gar[3])};
                float z[8];
#pragma unroll
                for (int c = 0; c < 8; ++c) z[c] = ov[c] * rn * hg[c] * gav[c];
                u32x4 oa = {cvt_pk_bf16(z[0], z[1]), cvt_pk_bf16(z[2], z[3]), cvt_pk_bf16(z[4], z[5]), cvt_pk_bf16(z[6], z[7])};
                *(u32x4*)(A2 + token * 1024 + ch0) = oa;
            }
    }
}

__device__ void final_phase(const Params& p) {
    const int tid = threadIdx.x, w = tid >> 6, lane = tid & 63;
    const float* modp = (const float*)(p.ws + WS_MODP);
    const bf16_t* Y = (const bf16_t*)(p.ws + WS_QF);
    const int rows_per = NLAT / gridDim.x;
    for (int r0 = blockIdx.x * rows_per; r0 < NLAT; r0 += gridDim.x * rows_per) {
        const int rend = min(r0 + rows_per, NLAT);
        int curb = -1; f32x4 gt[4], g[4];
#pragma unroll
        for (int c = 0; c < 4; ++c) { g[c] = *(const f32x4*)(p.final_norm_g + c * 256 + lane * 4); gt[c] = (f32x4){0.f, 0.f, 0.f, 0.f}; }
        for (int row = r0 + w * 2; row < rend; row += 16) {
            const int b = row >> 12;
            if (b != curb) { curb = b;
#pragma unroll
                for (int c = 0; c < 4; ++c) { f32x4 t = *(const f32x4*)(p.b_mod + 2048 + c * 256 + lane * 4);
#pragma unroll
                    for (int q = 0; q < 4; ++q) t += *(const f32x4*)(modp + (q * 9 + b) * 3072 + 2048 + c * 256 + lane * 4);
                    gt[c] = t; } }
            const float* xp = p.x + (size_t)row * 1024; const bf16_t* yp = Y + (size_t)row * 1024; float* op = p.out + (size_t)row * 1024;
            f32x4 h0[4], h1[4]; float s0 = 0.f, s1 = 0.f;
#pragma unroll
            for (int c = 0; c < 4; ++c) {
                const f32x4 x0 = *(const f32x4*)(xp + c * 256 + lane * 4), x1 = *(const f32x4*)(xp + 1024 + c * 256 + lane * 4);
                const u32x2 y0 = *(const u32x2*)(yp + c * 256 + lane * 4), y1 = *(const u32x2*)(yp + 1024 + c * 256 + lane * 4);
                h0[c] = x0 + gt[c] * (f32x4){bf_lo(y0[0]), bf_hi(y0[0]), bf_lo(y0[1]), bf_hi(y0[1])};
                h1[c] = x1 + gt[c] * (f32x4){bf_lo(y1[0]), bf_hi(y1[0]), bf_lo(y1[1]), bf_hi(y1[1])};
                s0 += h0[c][0] * h0[c][0] + h0[c][1] * h0[c][1] + h0[c][2] * h0[c][2] + h0[c][3] * h0[c][3];
                s1 += h1[c][0] * h1[c][0] + h1[c][1] * h1[c][1] + h1[c][2] * h1[c][2] + h1[c][3] * h1[c][3];
            }
#pragma unroll
            for (int m = 32; m >= 1; m >>= 1) { s0 += __shfl_xor(s0, m); s1 += __shfl_xor(s1, m); }
            const float rs0 = rsqrtf(s0 * (1.f / 1024.f) + EPS), rs1 = rsqrtf(s1 * (1.f / 1024.f) + EPS);
#pragma unroll
            for (int c = 0; c < 4; ++c) { *(f32x4*)(op + c * 256 + lane * 4) = h0[c] * rs0 * g[c]; *(f32x4*)(op + 1024 + c * 256 + lane * 4) = h1[c] * rs1 * g[c]; }
        }
    }
}

__global__ void __launch_bounds__(NTHR, 2) hymba_fwd(Params p) {
    extern __shared__ __attribute__((aligned(16))) unsigned char lds_raw[];
    LAS unsigned char* lds = (LAS unsigned char*)lds_raw;
    const int lo = p.ph_lo, hi = p.ph_hi;
#define IN(k) (lo <= (k) && (k) < hi)
#if N_LAUNCHES == 1
    volatile LAS unsigned* bst = (volatile LAS unsigned*)(lds + 131072);
    if (threadIdx.x < 4) bst[threadIdx.x] = 0u;
    __syncthreads();
    const XcdBarrier bar = xcd_barrier_post((unsigned*)(p.ws + WS_BAR), bst);
#define SEAM(k) do { if (IN(k) && IN((k) + 1)) xcd_barrier(bar); } while (0)
#else
#define SEAM(k) do { } while (0)
#endif
#ifndef DUP_PHASE
#define DUP_PHASE -1
#endif
    if (IN(0)) phase0(lds, p, 0, 192 + 1280);
    SEAM(0);
    if (IN(1)) phase1(lds, p);
    SEAM(1);
    if (IN(2)) {
        pg8::Gemm g{(const bf16_t*)(p.ws + WS_A), (const bf16_t*)(p.ws + WS_WIN), NROWS, 4096, 1024};
        pg8::InOrder S; S.init(NLAT, 4096, gridDim.x, blockIdx.x);
        EpiIn E{p.ws, p.lb_logits};
#pragma unroll 1
        for (int rep = 0; rep < (DUP_PHASE == 2 ? 2 : 1); ++rep) pg8::gemm_phase<EpiIn, pg8::InOrder>(lds, g, S, E);
    }
    SEAM(2);
    if (IN(3)) {
#pragma unroll 1
        for (int rep = 0; rep < (DUP_PHASE == 3 ? 2 : 1); ++rep) scan_phase(lds, p);
    }
    SEAM(3);
    if (IN(4)) { conv_phase(lds, p); if (DUP_PHASE == 4) { __syncthreads(); conv_phase(lds, p); } }
    SEAM(4);
    if (IN(5)) {
        pg8::Gemm g{(const bf16_t*)(p.ws + WS_A), (const bf16_t*)(p.ws + WS_WOUT), NLAT, 1024, 1024};
        pg8::StaticOrder S; S.init(NLAT, 1024, gridDim.x, blockIdx.x);
        EpiOut E{(bf16_t*)(p.ws + WS_QF)};
#pragma unroll 1
        for (int rep = 0; rep < (DUP_PHASE == 5 ? 2 : 1); ++rep) pg8::gemm_phase<EpiOut, pg8::StaticOrder>(lds, g, S, E);
    }
    SEAM(5);
    if (IN(6)) final_phase(p);
}

extern "C" void kernel_launch(void* const* d_in, const int* in_sizes, int n_in, void* d_out, int out_size, void* d_ws, size_t ws_size, hipStream_t stream) {
    static int grid = 0;
    if (grid == 0) {
        int dev = 0, cus = 0, per_cu = 0;
        hipGetDevice(&dev);
        hipDeviceGetAttribute(&cus, hipDeviceAttributeMultiprocessorCount, dev);
        hipFuncSetAttribute((const void*)hymba_fwd, hipFuncAttributeMaxDynamicSharedMemorySize, LDS_BYTES);
        hipOccupancyMaxActiveBlocksPerMultiprocessor(&per_cu, (const void*)hymba_fwd, NTHR, LDS_BYTES);
        if (per_cu < 1) { fprintf(stderr, "kernel_launch: occupancy query says %d blocks/CU\n", per_cu); per_cu = 1; }
        grid = cus * per_cu;
        if (ws_size < WS_END) { fprintf(stderr, "kernel_launch: workspace too small (%zu < %zu)\n", ws_size, (size_t)WS_END); grid = -1; }
    }
    if (grid < 0) return;
    Params p{};
    p.x = (const float*)d_in[0]; p.c = (const float*)d_in[1]; p.ctx = (const float*)d_in[2]; p.c_ctx = (const float*)d_in[3]; p.norm_g = (const float*)d_in[4];
    p.w_mod = (const float*)d_in[5]; p.b_mod = (const float*)d_in[6]; p.w_in = (const float*)d_in[7]; p.lb_logits = (const float*)d_in[8]; p.hgrn_norm_g = (const float*)d_in[9];
    p.conv_w = (const float*)d_in[10]; p.conv_b = (const float*)d_in[11]; p.conv_ln_g = (const float*)d_in[12]; p.conv_ln_b = (const float*)d_in[13]; p.w_out = (const float*)d_in[14];
    p.final_norm_g = (const float*)d_in[15];
    p.out = (float*)d_out; p.ws = (unsigned char*)d_ws;
#if N_LAUNCHES == 1
    p.ph_lo = 0; p.ph_hi = 7;
    hipMemsetAsync((unsigned char*)d_ws + WS_BAR, 0, XCD_BAR_WORDS * 4, stream);
    void* args[] = {&p};
    hipError_t e = hipLaunchCooperativeKernel((const void*)hymba_fwd, dim3(grid), dim3(NTHR), args, LDS_BYTES, stream);
    if (e != hipSuccess) fprintf(stderr, "cooperative launch failed: %s (grid %d)\n", hipGetErrorString(e), grid);
#else
    for (int ph = 0; ph < 7; ++ph) { p.ph_lo = ph; p.ph_hi = ph + 1; hipLaunchKernelGGL(hymba_fwd, dim3(grid), dim3(NTHR), LDS_BYTES, stream, p); }
#endif
}
```

```cpp
#include <hip/hip_runtime.h>
#include <hip/hip_cooperative_groups.h>
#include <cstdio>
namespace cg = cooperative_groups;

#ifndef N_LAUNCHES
#define N_LAUNCHES 1
#endif

#define LAS __attribute__((address_space(3)))
typedef unsigned short bf16_t;
typedef short bf16x8 __attribute__((ext_vector_type(8)));
typedef float f32x4 __attribute__((ext_vector_type(4)));
typedef float f32x2 __attribute__((ext_vector_type(2)));
typedef unsigned u32x4 __attribute__((ext_vector_type(4)));
typedef unsigned u32x2 __attribute__((ext_vector_type(2)));

constexpr int NTHR = 512;
constexpr int DM = 1024, NLAT = 32768, NROWS = 34816;
constexpr int NCHUNK = NROWS / 64;
constexpr float EPS = 1e-6f;
constexpr int LDS_BYTES = 131072 + 16;

constexpr size_t WS_WIN = 0;
constexpr size_t WS_WOUT = 8388608;
constexpr size_t WS_MODP = 10485760;
constexpr size_t WS_RSS = 11010048;
constexpr size_t WS_BAR = 13107200;
constexpr size_t WS_A = 13631488;
constexpr size_t SZ_S = (size_t)NROWS * 512 * 2, SZ_L = (size_t)NLAT * 512 * 2;
constexpr size_t WS_QF = WS_A + (size_t)NROWS * 1024 * 2;
constexpr size_t WS_QB = WS_QF + SZ_S;
constexpr size_t WS_KF = WS_QB + SZ_S;
constexpr size_t WS_KB = WS_KF + SZ_S;
constexpr size_t WS_V = WS_KB + SZ_S;
constexpr size_t WS_GA = WS_V + SZ_S;
constexpr size_t WS_G = WS_GA + SZ_L;
constexpr size_t WS_GB = WS_G + SZ_L;
constexpr size_t WS_RT = WS_GB + SZ_L;
constexpr size_t WS_END = WS_RT + (size_t)2 * 2 * NCHUNK * 512 * 4;

struct Params {
    const float *x, *c, *ctx, *c_ctx, *norm_g, *w_mod, *b_mod, *w_in, *lb_logits, *hgrn_norm_g, *conv_w, *conv_b, *conv_ln_g, *conv_ln_b, *w_out, *final_norm_g;
    float* out; unsigned char* ws; int ph_lo, ph_hi;
};

__device__ __forceinline__ unsigned cvt_pk_bf16(float lo, float hi) { unsigned r; asm volatile("v_cvt_pk_bf16_f32 %0, %1, %2" : "=v"(r) : "v"(lo), "v"(hi)); return r; }
__device__ __forceinline__ unsigned cvt_pk_bf16_mfma(float lo, float hi) { unsigned r; asm volatile("s_nop 15\n\ts_nop 7\n\tv_cvt_pk_bf16_f32 %0, %1, %2" : "=v"(r) : "v"(lo), "v"(hi)); return r; }
__device__ __forceinline__ float bf_lo(unsigned u) { return __uint_as_float(u << 16); }
__device__ __forceinline__ float bf_hi(unsigned u) { return __uint_as_float(u & 0xffff0000u); }
__device__ __forceinline__ float sigmoidf_(float v) { return __builtin_amdgcn_rcpf(1.f + __expf(-v)); }
__device__ __forceinline__ float siluf_(float v) { return v * __builtin_amdgcn_rcpf(1.f + __expf(-v)); }


#define XB_TMO      128
#define XB_XCNT(j)  (256  + 64 * (j))
#define XB_XSUB(j)  (1280 + 64 * (j))
#define XB_XGEN(j)  (2304 + 64 * (j))
#define XB_TOP      3328
#define XB_TOPGEN   3392
#define XCD_BAR_WORDS 3456
#define XB_SPIN_CAP (1u << 18)
__device__ __forceinline__ unsigned xb_ld(unsigned* p)              { return __hip_atomic_load(p, __ATOMIC_RELAXED, __HIP_MEMORY_SCOPE_AGENT); }
__device__ __forceinline__ unsigned xb_add(unsigned* p, unsigned v) { return __hip_atomic_fetch_add(p, v, __ATOMIC_RELAXED, __HIP_MEMORY_SCOPE_AGENT); }
__device__ __forceinline__ unsigned xb_xcc_id() { return (unsigned)__builtin_amdgcn_s_getreg((3 << 11) | 20) & 0xFu; }
#define XB_SPIN(cond, bar) do { unsigned _sp = 0; while (cond) { __builtin_amdgcn_s_sleep(1); \
    if ((++_sp & 255u) == 0u) { if (xb_ld(&(bar)[XB_TMO])) break; if (_sp > XB_SPIN_CAP) { atomicAdd(&(bar)[XB_TMO], 1u); break; } } } } while (0)
struct XcdBarrier { unsigned* bar; unsigned x; volatile LAS unsigned* st; };
__device__ __forceinline__ XcdBarrier xcd_barrier_post(unsigned* bar, volatile LAS unsigned* st) {
    XcdBarrier b; b.bar = bar; b.x = xb_xcc_id(); b.st = st;
    if (threadIdx.x == 0) (void)xb_add(&bar[XB_XCNT(b.x)], 1u);
    return b;
}
__device__ __forceinline__ void xcd_barrier_complete(unsigned* bar, unsigned x, unsigned& nloc, unsigned& nx) {
    const unsigned G = gridDim.x * gridDim.y * gridDim.z;
    unsigned sum, cnt, mine, sp = 0u;
    for (;;) {
        sum = 0u; cnt = 0u; mine = 0u;
#pragma unroll
        for (unsigned j = 0; j < 16; ++j) { const unsigned c = xb_ld(&bar[XB_XCNT(j)]); sum += c; cnt += (c > 0u) ? 1u : 0u; mine = (j == x) ? c : mine; }
        if (sum == G) break;
        __builtin_amdgcn_s_sleep(1);
        if ((++sp & 255u) == 0u) { if (xb_ld(&bar[XB_TMO])) break; if (sp > XB_SPIN_CAP) { atomicAdd(&bar[XB_TMO], 1u); break; } }
    }
    nloc = mine > 0u ? mine : 1u; nx = cnt > 0u ? cnt : 1u;
}
__device__ __forceinline__ void xcd_barrier(const XcdBarrier& b) {
    asm volatile("s_waitcnt vmcnt(0)" ::: "memory");
    __syncthreads();
    if (threadIdx.x == 0) {
        unsigned* bar = b.bar;
        __builtin_amdgcn_s_waitcnt(0);
        unsigned nloc = b.st[0], nx = b.st[1];
        if (nloc == 0u) { xcd_barrier_complete(bar, b.x, nloc, nx); b.st[0] = nloc; b.st[1] = nx; }
        const unsigned old = xb_add(&bar[XB_XSUB(b.x)], 1u);
        const unsigned gen = old / nloc;
        if (old + 1u == (gen + 1u) * nloc) {
            __builtin_amdgcn_fence(__ATOMIC_RELEASE, "agent");
            asm volatile("s_waitcnt vmcnt(0)" ::: "memory");
            const unsigned og = xb_add(&bar[XB_TOP], 1u);
            const unsigned tg = og / nx;
            if (og + 1u == (tg + 1u) * nx) xb_add(&bar[XB_TOPGEN], 1u);
            else XB_SPIN(xb_ld(&bar[XB_TOPGEN]) == tg, bar);
            __builtin_amdgcn_fence(__ATOMIC_ACQUIRE, "agent");
            xb_add(&bar[XB_XGEN(b.x)], 1u);
            asm volatile("s_waitcnt vmcnt(0)" ::: "memory");
        } else {
            XB_SPIN(xb_ld(&bar[XB_XGEN(b.x)]) == gen, bar);
            __builtin_amdgcn_fence(__ATOMIC_ACQUIRE, "agent");
            asm volatile("s_waitcnt vmcnt(0)" ::: "memory");
        }
    }
    __syncthreads();
}

namespace pg8 {
constexpr int BM = 256, BK = 64, HALF = 128, HTB = HALF * BK * 2, STAGE_BYTES = 8 * HTB, NXCD = 8, WGM = 8;
__host__ __device__ __forceinline__ int lds_byte(int r, int c) { const int st = (r >> 4) * 2 + (c >> 5), rr = r & 15, cc = c & 31, ob = rr * 64 + cc * 2; return st * 1024 + (ob ^ (((ob >> 9) & 1) << 5)); }
__host__ __device__ __forceinline__ void stage_rc(int b, int& R, int& C) { const int st = b / 1024, sb = b % 1024, swz = sb ^ (((sb >> 9) & 1) << 5); R = (st >> 1) * 16 + swz / 64; C = (st & 1) * 32 + (swz % 64) / 2; }
__host__ __device__ __forceinline__ int perm32(int rho) { const int n = rho >> 4, i = rho & 15; return 8 * (i >> 2) + 4 * n + (i & 3); }
struct Unit { int pm, pn; };
struct Gemm { const bf16_t* A; const bf16_t* Bt; int M, N, K; };
struct StaticOrder {
    int nM, nN, nwg, G, c;
    __device__ void init(int M, int N, int G_, int c_) { nM = M / BM; nN = N / BM; nwg = nM * nN; G = G_; c = c_; }
    __device__ bool map(int L, Unit& u) const {
        int wgid = L; { const int q = nwg / NXCD, r = nwg % NXCD, xcd = wgid % NXCD, off = wgid / NXCD; wgid = (xcd < r ? xcd * (q + 1) : r * (q + 1) + (xcd - r) * q) + off; }
        const int nig = WGM * nN, gid = wgid / nig, fm = gid * WGM, gsz = (nM - fm) < WGM ? (nM - fm) : WGM;
        u.pm = fm + ((wgid % nig) % gsz); u.pn = (wgid % nig) / gsz; return true;
    }
    __device__ bool next(int i, Unit& u) const { const long L = (long)i * G + c; if (L >= nwg) return false; return map((int)L, u); }
};
struct InOrder : StaticOrder {
    __device__ bool next(int i, Unit& u) const {
        const long L = (long)i * G + c;
        if (L < nwg) return map((int)L, u);
        const int k = (int)(L - nwg); if (k >= 64) return false;
        u.pm = 128 + (k >> 3); u.pn = k & 7; return true;
    }
};

template <class Epi, class Sched>
__device__ __forceinline__ void gemm_phase(LAS unsigned char* lds, const Gemm g, const Sched& S, const Epi& E) {
    const int tid = threadIdx.x, wid = __builtin_amdgcn_readfirstlane(tid >> 6), lane = tid & 63, wr = wid >> 2, wc = wid & 3, fr = lane & 15, fq = lane >> 4;
    const int K = g.K, nt = K / BK;
    unsigned voffA[2], voffB[2];
#pragma unroll
    for (int i = 0; i < 2; ++i) { int R, C; stage_rc(tid * 16 + i * 8192, R, C); const int Rb = Epi::PERM ? ((R & ~31) + perm32(R & 31)) : R;
        voffA[i] = (unsigned)(R * K + C) * 2u; voffB[i] = (unsigned)(Rb * K + C) * 2u; }
    const size_t kstep = (size_t)(BK * 2);
    const size_t hstep = (size_t)HALF * K * 2;
    const size_t tstep = 2 * hstep;
    const unsigned ldsw = (unsigned)wid * 1024u;
    const int aoff = lds_byte(wr * 64 + fr, fq * 8), boff = lds_byte(wc * 32 + fr, fq * 8);
#define PG8_SA(b, h) (((b) * 2 + (h)) * HTB)
#define PG8_SB(b, h) ((4 + (b) * 2 + (h)) * HTB)
#define PG8_STAGE(bufoff, gbase, voff) do { _Pragma("unroll") for (int _i = 0; _i < 2; ++_i) \
        __builtin_amdgcn_global_load_lds((const unsigned*)((const char*)(gbase) + (voff)[_i]), (LAS unsigned*)(lds + (bufoff) + ldsw + _i * 8192), 16, 0, 0); } while (0)
#define PG8_LDA(dst, b, h) do { _Pragma("unroll") for (int m = 0; m < 4; ++m) _Pragma("unroll") for (int k = 0; k < 2; ++k) dst[m][k] = *(const LAS bf16x8*)(lds + PG8_SA(b, h) + aoff + m * 2048 + k * 1024); } while (0)
#define PG8_LDB(dst, b, h) do { _Pragma("unroll") for (int n = 0; n < 2; ++n) _Pragma("unroll") for (int k = 0; k < 2; ++k) dst[n][k] = *(const LAS bf16x8*)(lds + PG8_SB(b, h) + boff + n * 2048 + k * 1024); } while (0)
#define PG8_MMA(ai, bj, At, Bt) do { __builtin_amdgcn_s_setprio(1); _Pragma("unroll") for (int m = 0; m < 4; ++m) _Pragma("unroll") for (int n = 0; n < 2; ++n) _Pragma("unroll") for (int k = 0; k < 2; ++k) \
        acc[ai][bj][m][n] = __builtin_amdgcn_mfma_f32_16x16x32_bf16(Bt[n][k], At[m][k], acc[ai][bj][m][n], 0, 0, 0); __builtin_amdgcn_s_setprio(0); } while (0)
#define PG8_WAIT_V(n) asm volatile("s_waitcnt vmcnt(" #n ")" ::: "memory")
#define PG8_WAIT_L(n) asm volatile("s_waitcnt lgkmcnt(" #n ")" ::: "memory")
#define PG8_BAR __builtin_amdgcn_s_barrier()
#define PG8_SCHED __builtin_amdgcn_sched_barrier(0)
    Unit cur, nxt; int ui = 0;
    if (!S.next(0, cur)) return;
    f32x4 acc[2][2][4][2];
#pragma unroll
    for (int a = 0; a < 2; ++a)
#pragma unroll
        for (int b = 0; b < 2; ++b)
#pragma unroll
            for (int m = 0; m < 4; ++m)
#pragma unroll
                for (int n = 0; n < 2; ++n) acc[a][b][m][n] = (f32x4){0.f, 0.f, 0.f, 0.f};
    bf16x8 At[4][2], B0[2][2], B1[2][2];
    const char* cA = (const char*)g.A + (size_t)cur.pm * tstep; const char* cB = (const char*)g.Bt + (size_t)cur.pn * tstep;
    PG8_STAGE(PG8_SB(0, 0), cB, voffB); PG8_STAGE(PG8_SA(0, 0), cA, voffA); PG8_STAGE(PG8_SB(0, 1), cB + hstep, voffB); PG8_STAGE(PG8_SA(0, 1), cA + hstep, voffA);
    if (wr == 1) PG8_BAR;
    PG8_WAIT_V(4); PG8_BAR;
    PG8_STAGE(PG8_SB(1, 0), cB + kstep, voffB); PG8_STAGE(PG8_SA(1, 0), cA + kstep, voffA); PG8_STAGE(PG8_SB(1, 1), cB + hstep + kstep, voffB);
    PG8_WAIT_V(6); PG8_BAR;
    for (;;) {
        const bool has_next = S.next(ui + 1, nxt);
        const char* nA = has_next ? (const char*)g.A + (size_t)nxt.pm * tstep : cA; const char* nB = has_next ? (const char*)g.Bt + (size_t)nxt.pn * tstep : cB;
        for (int t = 0; t < nt; t += 2) {
            const bool last = (t == nt - 2);
            const char* a1 = cA + (size_t)(t + 1) * kstep;
            const char* a2 = last ? nA : cA + (size_t)(t + 2) * kstep; const char* b2 = last ? nB : cB + (size_t)(t + 2) * kstep;
            const char* a3 = a2 + kstep; const char* b3 = b2 + kstep;
            PG8_LDB(B0, 0, 0); PG8_SCHED; PG8_LDA(At, 0, 0); PG8_STAGE(PG8_SA(1, 1), a1 + hstep, voffA);
            PG8_WAIT_L(8); PG8_BAR; PG8_WAIT_L(0); PG8_MMA(0, 0, At, B0); PG8_BAR; PG8_SCHED;
            PG8_LDB(B1, 0, 1); PG8_STAGE(PG8_SB(0, 0), b2, voffB);
            PG8_BAR; PG8_WAIT_L(0); PG8_MMA(0, 1, At, B1); PG8_BAR;
            PG8_LDA(At, 0, 1); PG8_STAGE(PG8_SA(0, 0), a2, voffA);
            PG8_BAR; PG8_WAIT_L(0); PG8_MMA(1, 0, At, B0); PG8_BAR; PG8_SCHED;
            PG8_STAGE(PG8_SB(0, 1), b2 + hstep, voffB);
            PG8_WAIT_V(6); PG8_BAR; PG8_MMA(1, 1, At, B1); PG8_BAR;
            PG8_LDB(B0, 1, 0); PG8_SCHED; PG8_LDA(At, 1, 0); PG8_STAGE(PG8_SA(0, 1), a2 + hstep, voffA);
            PG8_WAIT_L(8); PG8_BAR; PG8_WAIT_L(0); PG8_MMA(0, 0, At, B0); PG8_BAR; PG8_SCHED;
            PG8_LDB(B1, 1, 1); PG8_STAGE(PG8_SB(1, 0), b3, voffB);
            PG8_BAR; PG8_WAIT_L(0); PG8_MMA(0, 1, At, B1); PG8_BAR;
            PG8_LDA(At, 1, 1); PG8_STAGE(PG8_SA(1, 0), a3, voffA);
            PG8_BAR; PG8_WAIT_L(0); PG8_MMA(1, 0, At, B0); PG8_BAR; PG8_SCHED;
            PG8_STAGE(PG8_SB(1, 1), b3 + hstep, voffB);
            PG8_WAIT_V(6); PG8_BAR; PG8_MMA(1, 1, At, B1); PG8_BAR;
        }
        if (wr == 0) PG8_BAR;
        if (wr == 1) __builtin_amdgcn_s_setprio(1);
        E(acc, cur, wr, wc, fr, fq);
        __builtin_amdgcn_s_setprio(0);
        if (wr == 1) PG8_BAR;
        if (!has_next) break;
#pragma unroll
        for (int a = 0; a < 2; ++a)
#pragma unroll
            for (int b = 0; b < 2; ++b)
#pragma unroll
                for (int m = 0; m < 4; ++m)
#pragma unroll
                    for (int n = 0; n < 2; ++n) acc[a][b][m][n] = (f32x4){0.f, 0.f, 0.f, 0.f};
        cur = nxt; cA = nA; cB = nB; ++ui;
    }
    PG8_WAIT_V(0);
    if (wr == 0) PG8_BAR;
    PG8_BAR;
#undef PG8_SA
#undef PG8_SB
#undef PG8_STAGE
#undef PG8_LDA
#undef PG8_LDB
#undef PG8_MMA
#undef PG8_WAIT_V
#undef PG8_WAIT_L
#undef PG8_BAR
#undef PG8_SCHED
}
}

template <int K> __device__ __forceinline__ float dpp_shr(float x) { return __int_as_float(__builtin_amdgcn_update_dpp(0, __float_as_int(x), 0x110 + K, 0xf, 0xf, true)); }
__device__ __forceinline__ float scan16(float x) { x += dpp_shr<1>(x); x += dpp_shr<2>(x); x += dpp_shr<4>(x); x += dpp_shr<8>(x); return x; }
__device__ __forceinline__ float clamp80(float x) { return fminf(fmaxf(x, -80.f), 80.f); }
struct EpiIn {
    static constexpr bool PERM = true;
    unsigned char* ws; const float* lb_logits;
    __device__ __forceinline__ void operator()(const f32x4 (&acc)[2][2][4][2], const pg8::Unit& u, int wr, int wc, int fr, int fq) const {
        asm volatile("s_nop 15\n\ts_nop 15\n\ts_nop 15\n\ts_nop 15" ::: "memory");
        const int row0 = u.pm * 256 + wr * 64 + fr, pn = u.pn;
        if (pn < 8) {
            bf16_t* QF = (bf16_t*)(ws + WS_QF); bf16_t* QB = (bf16_t*)(ws + WS_QB); bf16_t* KF = (bf16_t*)(ws + WS_KF); bf16_t* KB = (bf16_t*)(ws + WS_KB); bf16_t* V = (bf16_t*)(ws + WS_V);
            float* RT = (float*)(ws + WS_RT);
            const int ch0 = 64 * pn + 16 * wc + 4 * fq;
            float lbF[4], lbB[4];
#pragma unroll
            for (int j = 0; j < 4; ++j) { lbF[j] = 1.f / (1.f + __expf(lb_logits[1024 + ch0 + j] - lb_logits[ch0 + j])); lbB[j] = 1.f / (1.f + __expf(lb_logits[1536 + ch0 + j] - lb_logits[512 + ch0 + j])); }
#pragma unroll
            for (int ai = 0; ai < 2; ++ai) {
                const int rowc = u.pm * 256 + 128 * ai + 64 * wr;
                const int cid = rowc >> 6;
                unsigned oQF[4][2], oQB[4][2], oKF[4][2], oKB[4][2]; f32x4 rtv[4];
#pragma unroll
                for (int jp = 0; jp < 2; ++jp) {
                    float vQF[4][2], vQB[4][2], vKF[4][2], vKB[4][2];
#pragma unroll
                    for (int jj = 0; jj < 2; ++jj) {
                        const int j = 2 * jp + jj;
                        float lfF[4], kkF[4], lfB[4], kkB[4], pF[4], pB[4], tF[4], tB[4];
#pragma unroll
                        for (int m = 0; m < 4; ++m) {
                            { const float z = acc[ai][0][m][1][j]; const float e = __expf(fminf(-z, 30.f)); const float s = __builtin_amdgcn_rcpf(1.f + e); lfF[m] = __logf(lbF[j] + (1.f - lbF[j]) * s); kkF[m] = (1.f - lbF[j]) * e * s; }
                            { const float z = acc[ai][1][m][0][j]; const float e = __expf(fminf(-z, 30.f)); const float s = __builtin_amdgcn_rcpf(1.f + e); lfB[m] = __logf(lbB[j] + (1.f - lbB[j]) * s); kkB[m] = (1.f - lbB[j]) * e * s; }
                            pF[m] = scan16(lfF[m]); pB[m] = scan16(lfB[m]);
                            tF[m] = __int_as_float(__builtin_amdgcn_update_dpp(0, __float_as_int(pF[m]), 0x15F, 0xf, 0xf, true));
                            tB[m] = __int_as_float(__builtin_amdgcn_update_dpp(0, __float_as_int(pB[m]), 0x15F, 0xf, 0xf, true));
                        }
                        const float rF = tF[0] + tF[1], blF = rF + tF[2] + tF[3];
                        const float rB = tB[2] + tB[3], blB = rB + tB[0] + tB[1];
                        float cF = 0.f, cB = 0.f;
#pragma unroll
                        for (int m = 0; m < 4; ++m) {
                            const float bF = pF[m] + cF; cF += tF[m];
                            const float bB = blB - (pB[m] + cB) + lfB[m]; cB += tB[m];
                            const float xF = clamp80(bF - rF), xB = clamp80(bB - rB);
                            const float q = acc[ai][0][m][0][j];
                            vQF[m][jj] = q * __expf(xF); vKF[m][jj] = kkF[m] * __expf(-xF);
                            vQB[m][jj] = q * __expf(xB); vKB[m][jj] = kkB[m] * __expf(-xB);
                        }
                        rtv[0][j] = rF; rtv[1][j] = rB; rtv[2][j] = blF - rF; rtv[3][j] = blB - rB;
                    }
#pragma unroll
                    for (int m = 0; m < 4; ++m) { oQF[m][jp] = cvt_pk_bf16(vQF[m][0], vQF[m][1]); oQB[m][jp] = cvt_pk_bf16(vQB[m][0], vQB[m][1]); oKF[m][jp] = cvt_pk_bf16(vKF[m][0], vKF[m][1]); oKB[m][jp] = cvt_pk_bf16(vKB[m][0], vKB[m][1]); }
                }
                if (fr == 0) {
#pragma unroll
                    for (int t = 0; t < 4; ++t) *(f32x4*)(RT + (size_t)t * NCHUNK * 512 + (size_t)cid * 512 + ch0) = rtv[t];
                }
#pragma unroll
                for (int mp = 0; mp < 2; ++mp) {
                    const int a = 2 * mp, bb = 2 * mp + 1, odd = fq & 1;
                    const size_t off = (size_t)(rowc + 16 * (odd ? bb : a) + fr) * 512 + (ch0 - 4 * odd);
                    const f32x4 va = acc[ai][1][a][1], vb = acc[ai][1][bb][1];
                    const unsigned oVa0 = cvt_pk_bf16(va[0], va[1]), oVa1 = cvt_pk_bf16(va[2], va[3]), oVb0 = cvt_pk_bf16(vb[0], vb[1]), oVb1 = cvt_pk_bf16(vb[2], vb[3]);
                    asm volatile("s_nop 1" ::: "memory");
#define WIDE_ST(P, x0a, x1a, x0b, x1b) do { const u32x2 s0 = __builtin_amdgcn_permlane16_swap((x0a), (x0b), false, false), s1 = __builtin_amdgcn_permlane16_swap((x1a), (x1b), false, false); \
                        *(u32x4*)((P) + off) = (u32x4){s0[0], s1[0], s0[1], s1[1]}; } while (0)
                    WIDE_ST(QF, oQF[a][0], oQF[a][1], oQF[bb][0], oQF[bb][1]); WIDE_ST(QB, oQB[a][0], oQB[a][1], oQB[bb][0], oQB[bb][1]);
                    WIDE_ST(KF, oKF[a][0], oKF[a][1], oKF[bb][0], oKF[bb][1]); WIDE_ST(KB, oKB[a][0], oKB[a][1], oKB[bb][0], oKB[bb][1]);
                    WIDE_ST(V, oVa0, oVa1, oVb0, oVb1);
#undef WIDE_ST
                }
            }
        } else if (pn >= 10 && pn <= 13) {
            bf16_t* G = (bf16_t*)(ws + WS_G);
            const int chb = 128 * (pn - 10) + 16 * wc + 4 * fq;
            const int odd = fq & 1;
#pragma unroll
            for (int ai = 0; ai < 2; ++ai)
#pragma unroll
                for (int mp = 0; mp < 2; ++mp) {
                    const size_t row = (size_t)(row0 + ai * 128 + (2 * mp + odd) * 16);
#pragma unroll
                    for (int bj = 0; bj < 2; ++bj) {
                        const f32x4 ua = acc[ai][bj][2 * mp][0], ga = acc[ai][bj][2 * mp][1], ub = acc[ai][bj][2 * mp + 1][0], gb = acc[ai][bj][2 * mp + 1][1];
                        const unsigned a0 = cvt_pk_bf16(ua[0] * sigmoidf_(ga[0]), ua[1] * sigmoidf_(ga[1])), a1 = cvt_pk_bf16(ua[2] * sigmoidf_(ga[2]), ua[3] * sigmoidf_(ga[3]));
                        const unsigned b0 = cvt_pk_bf16(ub[0] * sigmoidf_(gb[0]), ub[1] * sigmoidf_(gb[1])), b1 = cvt_pk_bf16(ub[2] * sigmoidf_(gb[2]), ub[3] * sigmoidf_(gb[3]));
                        asm volatile("s_nop 1" ::: "memory");
                        const u32x2 s0 = __builtin_amdgcn_permlane16_swap(a0, b0, false, false), s1 = __builtin_amdgcn_permlane16_swap(a1, b1, false, false);
                        *(u32x4*)(G + row * 512 + (chb - 4 * odd) + 64 * bj) = (u32x4){s0[0], s1[0], s0[1], s1[1]};
                    }
                }
        } else {
            bf16_t* D = (bf16_t*)(ws + (pn < 10 ? WS_GA : WS_GB));
            const int colb = 256 * (pn < 10 ? pn - 8 : pn - 14) + 32 * wc + 8 * fq;
#pragma unroll
            for (int ai = 0; ai < 2; ++ai)
#pragma unroll
                for (int m = 0; m < 4; ++m) {
                    const size_t row = (size_t)(row0 + ai * 128 + m * 16);
#pragma unroll
                    for (int bj = 0; bj < 2; ++bj) {
                        f32x4 v0 = acc[ai][bj][m][0], v1 = acc[ai][bj][m][1];
#pragma unroll
                        for (int j = 0; j < 4; ++j) { v0[j] = siluf_(v0[j]); v1[j] = siluf_(v1[j]); }
                        u32x4 o = {cvt_pk_bf16(v0[0], v0[1]), cvt_pk_bf16(v0[2], v0[3]), cvt_pk_bf16(v1[0], v1[1]), cvt_pk_bf16(v1[2], v1[3])};
                        *(u32x4*)(D + row * 512 + colb + 128 * bj) = o;
                    }
                }
        }
    }
};

struct EpiOut {
    static constexpr bool PERM = true;
    bf16_t* Y;
    __device__ __forceinline__ void operator()(const f32x4 (&acc)[2][2][4][2], const pg8::Unit& u, int wr, int wc, int fr, int fq) const {
        asm volatile("s_nop 15\n\ts_nop 15\n\ts_nop 15\n\ts_nop 15" ::: "memory");
        const int row0 = u.pm * 256 + wr * 64 + fr, col0 = u.pn * 256 + wc * 32 + 8 * fq;
#pragma unroll
        for (int ai = 0; ai < 2; ++ai)
#pragma unroll
            for (int m = 0; m < 4; ++m) {
                const size_t row = (size_t)(row0 + ai * 128 + m * 16);
#pragma unroll
                for (int bj = 0; bj < 2; ++bj) {
                    const f32x4 v0 = acc[ai][bj][m][0], v1 = acc[ai][bj][m][1];
                    u32x4 o = {cvt_pk_bf16(v0[0], v0[1]), cvt_pk_bf16(v0[2], v0[3]), cvt_pk_bf16(v1[0], v1[1]), cvt_pk_bf16(v1[2], v1[3])};
                    *(u32x4*)(Y + row * 1024 + col0 + 128 * bj) = o;
                }
            }
    }
};

__device__ void phase0(LAS unsigned char* lds, const Params& p, int it_lo, int it_hi) {
    const int tid = threadIdx.x;
    LAS float* fl = (LAS float*)lds;
    float* modp = (float*)(p.ws + WS_MODP);
    for (int it = it_lo + blockIdx.x; it < it_hi; it += gridDim.x) {
        if (it < 192) {
            const int cc = it % 48, kq = it / 48;
            LAS float* sil = fl; LAS float* red = fl + 2304;
            for (int i = tid; i < 2304; i += NTHR) { const int j = i >> 8, k = kq * 256 + (i & 255); const float v = (j < 8) ? p.c[j * 1024 + k] : p.c_ctx[k]; sil[i] = siluf_(v); }
            __syncthreads();
            const int n = tid & 63, ks = tid >> 6;
            const float* wp = p.w_mod + (size_t)(kq * 256 + ks * 32) * 3072 + cc * 64 + n;
            float a[9];
#pragma unroll
            for (int j = 0; j < 9; ++j) a[j] = 0.f;
#pragma unroll 8
            for (int kk = 0; kk < 32; ++kk) { const float w = wp[(size_t)kk * 3072];
#pragma unroll
                for (int j = 0; j < 9; ++j) a[j] += sil[j * 256 + ks * 32 + kk] * w; }
#pragma unroll
            for (int j = 0; j < 9; ++j) red[(ks * 9 + j) * 64 + n] = a[j];
            __syncthreads();
            for (int i = tid; i < 576; i += NTHR) { const int j = i >> 6, nn = i & 63; float s = 0.f;
#pragma unroll
                for (int k2 = 0; k2 < 8; ++k2) s += red[(k2 * 9 + j) * 64 + nn];
                modp[(kq * 9 + j) * 3072 + cc * 64 + nn] = s; }
            __syncthreads();
        } else {
            int t = it - 192; const float* W; bf16_t* WT; int N; bool isin;
            if (t < 1024) { W = p.w_in; WT = (bf16_t*)(p.ws + WS_WIN); N = 4096; isin = true; } else { t -= 1024; W = p.w_out; WT = (bf16_t*)(p.ws + WS_WOUT); N = 1024; isin = false; }
            const int kt = t & 15, nt = t >> 4;
            const int n = tid & 63, k0 = tid >> 6;
            const int ncol = nt * 64 + n; int src = ncol;
            if (isin && ncol < 2048) { const int pnn = ncol >> 8, cc = ncol & 255; const int type = ((cc >> 7) << 1) | ((cc >> 2) & 1); src = type * 512 + 64 * pnn + 16 * ((cc >> 5) & 3) + 4 * ((cc >> 3) & 3) + (cc & 3); }
            else if (isin && ncol >= 2560 && ncol < 3584) { const int mm = ncol - 2560, g = mm >> 3, i = mm & 7; src = (i < 4) ? 2560 + 4 * g + i : 3072 + 4 * g + (i - 4); }
#pragma unroll
            for (int ps = 0; ps < 8; ++ps) { const int k = ps * 8 + k0; fl[k * 65 + n] = W[(size_t)(kt * 64 + k) * N + src]; }
            __syncthreads();
            const int nn = tid >> 3, k8 = tid & 7;
            float v[8];
#pragma unroll
            for (int j = 0; j < 8; ++j) v[j] = fl[(k8 * 8 + j) * 65 + nn];
            u32x4 o = {cvt_pk_bf16(v[0], v[1]), cvt_pk_bf16(v[2], v[3]), cvt_pk_bf16(v[4], v[5]), cvt_pk_bf16(v[6], v[7])};
            *(u32x4*)(WT + (size_t)(nt * 64 + nn) * 1024 + kt * 64 + k8 * 8) = o;
            __syncthreads();
        }
    }
}

__device__ void phase1(LAS unsigned char* lds, const Params& p) {
    const int tid = threadIdx.x, w = tid >> 6, lane = tid & 63;
    LAS float* mv = (LAS float*)lds;
    const float* modp = (const float*)(p.ws + WS_MODP);
    bf16_t* A = (bf16_t*)(p.ws + WS_A);
    const int ngrp = NROWS / 8;
    const int g0 = (int)((long)blockIdx.x * ngrp / gridDim.x), g1 = (int)((long)(blockIdx.x + 1) * ngrp / gridDim.x);
    int curj = -1;
    for (int g = g0; g < g1; ++g) {
        const int row0 = g * 8; const int j = row0 < NLAT ? (row0 >> 12) : 8;
        if (j != curj) {
            __syncthreads();
            for (int i = tid; i < 1024; i += NTHR) { float sh = p.b_mod[i], sc = p.b_mod[1024 + i];
#pragma unroll
                for (int q = 0; q < 4; ++q) { sh += modp[(q * 9 + j) * 3072 + i]; sc += modp[(q * 9 + j) * 3072 + 1024 + i]; }
                mv[i] = p.norm_g[i] * (1.f + sc); mv[1024 + i] = sh; }
            __syncthreads(); curj = j;
        }
        const int row = row0 + w;
        const float* xr = row < NLAT ? p.x + (size_t)row * 1024 : p.ctx + (size_t)(row - NLAT) * 1024;
        f32x4 v[4]; float ss = 0.f;
#pragma unroll
        for (int c = 0; c < 4; ++c) { v[c] = *(const f32x4*)(xr + c * 256 + lane * 4); ss += v[c][0] * v[c][0] + v[c][1] * v[c][1] + v[c][2] * v[c][2] + v[c][3] * v[c][3]; }
#pragma unroll
        for (int m = 32; m >= 1; m >>= 1) ss += __shfl_xor(ss, m);
        const float rs = rsqrtf(ss * (1.f / 1024.f) + EPS);
#pragma unroll
        for (int c = 0; c < 4; ++c) { const int k = c * 256 + lane * 4; const f32x4 m0 = *(const LAS f32x4*)(mv + k), m1 = *(const LAS f32x4*)(mv + 1024 + k);
            const f32x4 a = v[c] * rs * m0 + m1; u32x2 o = {cvt_pk_bf16(a[0], a[1]), cvt_pk_bf16(a[2], a[3])}; *(u32x2*)(A + (size_t)row * 1024 + k) = o; }
    }
}

#define MFMA16(a, b, c) __builtin_amdgcn_mfma_f32_16x16x32_bf16((a), (b), (c), 0, 0, 0)
__device__ __forceinline__ int scan_cid(int n, int dir, int b) { return n < 4 ? 512 + b * 4 + (dir ? 3 - n : n) : b * 64 + (dir ? 67 - n : n - 4); }
#define SCAN_BAR() asm volatile("s_waitcnt lgkmcnt(0)\n\ts_barrier" ::: "memory")
#define SB_() __builtin_amdgcn_sched_barrier(0)
typedef short s16x4 __attribute__((ext_vector_type(4)));
__device__ __forceinline__ bf16x8 tr_pair(const LAS bf16_t* img, int stride, int r0a, int r0b, int c0, int ln) {
    const int q = ln >> 2, p = ln & 3;
    const s16x4 a = __builtin_amdgcn_ds_read_tr16_b64_v4i16((LAS s16x4*)(img + (r0a + q) * stride + c0 + 4 * p));
    const s16x4 b = __builtin_amdgcn_ds_read_tr16_b64_v4i16((LAS s16x4*)(img + (r0b + q) * stride + c0 + 4 * p));
    return __builtin_shufflevector(a, b, 0, 1, 2, 3, 4, 5, 6, 7);
}
__device__ void scan_phase(LAS unsigned char* lds, const Params& p) {
    const int tid = threadIdx.x, w = __builtin_amdgcn_readfirstlane(tid >> 6), lane = tid & 63, ln = lane & 15, lq = lane >> 4;
    constexpr int QST = 136, VST = 36;
    constexpr int OFF_KS = 17408, OFF_V = 34816, BUFB = 39424;
    LAS bf16_t* Sr = (LAS bf16_t*)(lds + 2 * BUFB);
    LAS float* scs = (LAS float*)(lds + 2 * BUFB + 9216);
    bf16_t* O = (bf16_t*)p.out;
    bf16_t* Odummy = (bf16_t*)(p.ws + WS_A) + (size_t)blockIdx.x * 64 * 512;
    const float* RT = (const float*)(p.ws + WS_RT);
    const int eb = w & 1, tb = w >> 1;
    if (w >= 4) __builtin_amdgcn_s_setprio(1);
    for (int item = blockIdx.x; item < 256; item += gridDim.x) {
        const int seq = (item & 7) + 8 * (item >> 5), es = (item >> 3) & 3;
        const int dir = seq & 1, h = (seq >> 1) & 3, b = seq >> 3;
        const char* Qx = (const char*)((const bf16_t*)(p.ws + (dir ? WS_QB : WS_QF)) + h * 128);
        const char* Kx = (const char*)((const bf16_t*)(p.ws + (dir ? WS_KB : WS_KF)) + h * 128);
        const char* Vx = (const char*)((const bf16_t*)(p.ws + WS_V) + h * 128 + es * 32);
        const char* Rx = (const char*)(RT + (size_t)dir * NCHUNK * 512 + h * 128);
        const char* Tx = (const char*)(RT + (size_t)(2 + dir) * NCHUNK * 512 + h * 128);
        const unsigned qoff0 = (unsigned)((dir ? 63 - (tid >> 4) : (tid >> 4)) * 1024 + (tid & 15) * 16), qstep = dir ? (unsigned)-32768 : 32768u;
        const unsigned voff = (unsigned)((dir ? 63 - (tid >> 3) : (tid >> 3)) * 1024 + (tid & 7) * 8), roff = (unsigned)(tid & 127) * 4u;
        f32x4 S[2] = {(f32x4){0.f, 0.f, 0.f, 0.f}, (f32x4){0.f, 0.f, 0.f, 0.f}};
        float tailp = 0.f;
        u32x4 k4A[2], k4B[2], k4C[2], k4D[2]; u32x4 q4A[2], q4B[2], q4C[2], q4D[2]; u32x2 v4A, v4B, v4C, v4D; float rvA, tlA, rvB, tlB, rvC, tlC, rvD, tlD;
#define SCAN_LOAD(n, k4, q4, v4, rv, tl) do { const size_t cb_ = (size_t)scan_cid((n), dir, b) * 65536; const size_t rb_ = (size_t)scan_cid((n), dir, b) * 2048; SB_(); \
            _Pragma("unroll") for (int i = 0; i < 2; ++i) { k4[i] = *(const u32x4*)(Kx + cb_ + (qoff0 + (unsigned)i * qstep)); SB_(); } \
            _Pragma("unroll") for (int i = 0; i < 2; ++i) { q4[i] = *(const u32x4*)(Qx + cb_ + (qoff0 + (unsigned)i * qstep)); SB_(); } \
            v4 = *(const u32x2*)(Vx + cb_ + voff); SB_(); rv = *(const float*)(Rx + rb_ + roff); SB_(); tl = *(const float*)(Tx + rb_ + roff); SB_(); } while (0)
#define SCAN_STAGE(bf, k4, q4, v4, rv, tl) do { LAS unsigned char* B_ = lds + (bf) * BUFB; \
            _Pragma("unroll") for (int i = 0; i < 2; ++i) { const int pc = tid + 512 * i; *(LAS u32x4*)(B_ + ((pc >> 4) * QST + (pc & 15) * 8) * 2) = q4[i]; *(LAS u32x4*)(B_ + OFF_KS + ((pc >> 4) * QST + (pc & 15) * 8) * 2) = k4[i]; } \
            *(LAS u32x2*)(B_ + OFF_V + ((tid >> 3) * VST + (tid & 7) * 4) * 2) = v4; \
            if (tid < 128) { scs[(bf) * 128 + tid] = __expf(rv + tailp); tailp = tl; } } while (0)
#define SCAN_MAT(bf, n) do { LAS unsigned char* B_ = lds + (bf) * BUFB; LAS bf16_t* Qs = (LAS bf16_t*)B_; LAS bf16_t* Ks = (LAS bf16_t*)(B_ + OFF_KS); LAS bf16_t* Vs = (LAS bf16_t*)(B_ + OFF_V); \
            _Pragma("unroll") for (int ti = 0; ti < 2; ++ti) { const int db = 2 * tb + ti; const float scv = scs[(bf) * 128 + 16 * db + ln]; S[ti] *= scv; \
                *(LAS u32x2*)(Sr + (16 * db + ln) * VST + 16 * eb + 4 * lq) = (u32x2){cvt_pk_bf16(S[ti][0], S[ti][1]), cvt_pk_bf16(S[ti][2], S[ti][3])}; } \
            bf16x8 Bq[4]; f32x4 pt[4]; \
            _Pragma("unroll") for (int ks = 0; ks < 4; ++ks) Bq[ks] = *(const LAS bf16x8*)(Qs + (16 * tb + ln) * QST + ks * 32 + lq * 8); \
            _Pragma("unroll") for (int sb = 0; sb < 4; ++sb) { pt[sb] = (f32x4){0.f, 0.f, 0.f, 0.f}; \
                if (sb <= tb) { f32x4 a = (f32x4){0.f, 0.f, 0.f, 0.f}; \
                    _Pragma("unroll") for (int ks = 0; ks < 4; ++ks) { const bf16x8 Ak = *(const LAS bf16x8*)(Ks + (16 * sb + ln) * QST + ks * 32 + lq * 8); a = MFMA16(Ak, Bq[ks], a); } \
                    if (sb == tb) { _Pragma("unroll") for (int i = 0; i < 4; ++i) if (4 * lq + i > ln) a[i] = 0.f; } \
                    pt[sb] = a; } } \
            SCAN_BAR(); \
            f32x4 o = (f32x4){0.f, 0.f, 0.f, 0.f}; \
            _Pragma("unroll") for (int ks = 0; ks < 4; ++ks) { const bf16x8 As = tr_pair(Sr, VST, 32 * ks + 8 * lq, 32 * ks + 8 * lq + 4, 16 * eb, ln); o = MFMA16(As, Bq[ks], o); } \
            _Pragma("unroll") for (int g = 0; g < 2; ++g) { if (2 * g <= tb) { \
                    const bf16x8 Av = tr_pair(Vs, VST, 32 * g + 4 * lq, 32 * g + 16 + 4 * lq, 16 * eb, ln); \
                    const u32x4 bp = {cvt_pk_bf16_mfma(pt[2 * g][0], pt[2 * g][1]), cvt_pk_bf16(pt[2 * g][2], pt[2 * g][3]), cvt_pk_bf16(pt[2 * g + 1][0], pt[2 * g + 1][1]), cvt_pk_bf16(pt[2 * g + 1][2], pt[2 * g + 1][3])}; \
                    o = MFMA16(Av, __builtin_bit_cast(bf16x8, bp), o); } } \
            { const int pos = 16 * tb + ln; const size_t row = (size_t)scan_cid((n), dir, b) * 64 + (dir ? 63 - pos : pos); \
              bf16_t* dst = ((n) >= 4) ? O + ((size_t)dir * NLAT + row) * 512 + h * 128 + es * 32 : Odummy + (size_t)pos * 512;     \
              *(u32x2*)(dst + 16 * eb + 4 * lq) = (u32x2){cvt_pk_bf16_mfma(o[0], o[1]), cvt_pk_bf16_mfma(o[2], o[3])}; } \
            _Pragma("unroll") for (int k2i = 0; k2i < 2; ++k2i) { const bf16x8 Av = tr_pair(Vs, VST, 32 * k2i + 8 * lq, 32 * k2i + 8 * lq + 4, 16 * eb, ln); \
                _Pragma("unroll") for (int ti = 0; ti < 2; ++ti) { const bf16x8 Bk = tr_pair(Ks, QST, 32 * k2i + 8 * lq, 32 * k2i + 8 * lq + 4, 16 * (2 * tb + ti), ln); S[ti] = MFMA16(Av, Bk, S[ti]); } } \
            } while (0)
        SCAN_LOAD(0, k4A, q4A, v4A, rvA, tlA); SCAN_LOAD(1, k4B, q4B, v4B, rvB, tlB); SCAN_LOAD(2, k4C, q4C, v4C, rvC, tlC); SCAN_LOAD(3, k4D, q4D, v4D, rvD, tlD);
        SCAN_STAGE(0, k4A, q4A, v4A, rvA, tlA); SCAN_LOAD(4, k4A, q4A, v4A, rvA, tlA);
        SCAN_BAR();
#pragma unroll 1
        for (int n0 = 0; n0 < 68; n0 += 4) {
            SCAN_STAGE(1, k4B, q4B, v4B, rvB, tlB); SCAN_LOAD(min(n0 + 5, 67), k4B, q4B, v4B, rvB, tlB); SCAN_MAT(0, n0); SCAN_BAR();
            SCAN_STAGE(0, k4C, q4C, v4C, rvC, tlC); SCAN_LOAD(min(n0 + 6, 67), k4C, q4C, v4C, rvC, tlC); SCAN_MAT(1, n0 + 1); SCAN_BAR();
            SCAN_STAGE(1, k4D, q4D, v4D, rvD, tlD); SCAN_LOAD(min(n0 + 7, 67), k4D, q4D, v4D, rvD, tlD); SCAN_MAT(0, n0 + 2); SCAN_BAR();
            SCAN_STAGE(0, k4A, q4A, v4A, rvA, tlA); SCAN_LOAD(min(n0 + 8, 67), k4A, q4A, v4A, rvA, tlA); SCAN_MAT(1, n0 + 3); SCAN_BAR();
        }
#undef SCAN_LOAD
#undef SCAN_STAGE
#undef SCAN_MAT
    }
    __builtin_amdgcn_s_setprio(0);
}

__device__ void conv_phase(LAS unsigned char* lds, const Params& p) {
    const int tid = threadIdx.x, w = tid >> 6, lane = tid & 63;
    LAS float* wl = (LAS float*)lds;
    for (int i = tid; i < 32 * 128; i += NTHR) ((LAS f32x4*)wl)[i] = (i < 31 * 128) ? ((const f32x4*)p.conv_w)[i] : (f32x4){0.f, 0.f, 0.f, 0.f};
    __syncthreads();
    const bf16_t* Gp = (const bf16_t*)(p.ws + WS_G); const bf16_t* GAp = (const bf16_t*)(p.ws + WS_GA); const bf16_t* GBp = (const bf16_t*)(p.ws + WS_GB);
    const bf16_t* O = (const bf16_t*)p.out;
    bf16_t* A2 = (bf16_t*)(p.ws + WS_A);
    const int half = lane >> 5, ch0 = lane * 8;
    for (int it = blockIdx.x * 8 + w; it < 8192; it += gridDim.x * 8) {
        const int b = it >> 10, r0 = ((it >> 5) & 31) * 2, c0 = (it & 31) * 2;
        float acc[4][8];
        const char* Pb = (const char*)Gp;
        const int base = half ? r0 : c0;
        const unsigned stepB = (half ? 64u : 1u) * 1024u;
#pragma unroll 1
        for (int line = 0; line < 2; ++line) {
            const int tok0 = half ? (c0 + line) : (r0 + line) * 64;
            const unsigned offb = (unsigned)((b * 4096 + tok0) * 512 + ch0) * 2u;
            asm volatile("" ::: "memory");
            float cur[2][8];
#pragma unroll
            for (int a = 0; a < 2; ++a)
#pragma unroll
                for (int c = 0; c < 8; ++c) cur[a][c] = 0.f;
            float Wp[8];
#pragma unroll
            for (int c = 0; c < 8; ++c) Wp[c] = 0.f;
#pragma unroll 1
            for (int hb = 0; hb < 4; ++hb) {
                u32x4 raw[8];
#pragma unroll
                for (int q = 0; q < 8; ++q) {
                    const int xx = base - 15 + hb * 8 + q;
                    const int xc = min(max(xx, 0), 63);
                    const u32x4 r = *(const u32x4*)(Pb + (offb + (unsigned)xc * stepB));
                    const bool ok = (xx == xc);
                    raw[q] = (u32x4){ok ? r[0] : 0u, ok ? r[1] : 0u, ok ? r[2] : 0u, ok ? r[3] : 0u};
                }
                const LAS float* wrow = wl + hb * 8 * 512 + ch0;
#pragma unroll
                for (int q = 0; q < 8; ++q) {
                    const float in[8] = {bf_lo(raw[q][0]), bf_hi(raw[q][0]), bf_lo(raw[q][1]), bf_hi(raw[q][1]), bf_lo(raw[q][2]), bf_hi(raw[q][2]), bf_lo(raw[q][3]), bf_hi(raw[q][3])};
                    const f32x4 wa = *(const LAS f32x4*)(wrow + q * 512), wb = *(const LAS f32x4*)(wrow + q * 512 + 4);
                    const float Wc[8] = {wa[0], wa[1], wa[2], wa[3], wb[0], wb[1], wb[2], wb[3]};
#pragma unroll
                    for (int c = 0; c < 8; ++c) { cur[0][c] += Wc[c] * in[c]; cur[1][c] += Wp[c] * in[c]; Wp[c] = Wc[c]; }
                }
            }
#pragma unroll
            for (int j = 0; j < 2; ++j)
#pragma unroll
                for (int c = 0; c < 8; ++c) { if (line == 0) acc[j][c] = cur[j][c]; else acc[2 + j][c] = cur[j][c]; }
        }
        float cbv[8], lg[8], lbv[8], hg[8];
        { const f32x4 a0 = *(const f32x4*)(p.conv_b + ch0), a1 = *(const f32x4*)(p.conv_b + ch0 + 4), b0 = *(const f32x4*)(p.conv_ln_g + ch0), b1 = *(const f32x4*)(p.conv_ln_g + ch0 + 4);
          const f32x4 d0 = *(const f32x4*)(p.conv_ln_b + ch0), d1 = *(const f32x4*)(p.conv_ln_b + ch0 + 4), e0 = *(const f32x4*)(p.hgrn_norm_g + ch0), e1 = *(const f32x4*)(p.hgrn_norm_g + ch0 + 4);
#pragma unroll
          for (int c = 0; c < 4; ++c) { cbv[c] = a0[c]; cbv[4 + c] = a1[c]; lg[c] = b0[c]; lg[4 + c] = b1[c]; lbv[c] = d0[c]; lbv[4 + c] = d1[c]; hg[c] = e0[c]; hg[4 + c] = e1[c]; } }
#pragma unroll
        for (int lr = 0; lr < 2; ++lr)
#pragma unroll
            for (int lc = 0; lc < 2; ++lc) {
                const size_t token = (size_t)b * 4096 + (r0 + lr) * 64 + (c0 + lc);
                float v[8]; float s1 = 0.f, s2 = 0.f;
#pragma unroll
                for (int c = 0; c < 8; ++c) { v[c] = (half ? acc[lc * 2 + lr][c] : acc[lr * 2 + lc][c]) + cbv[c]; s1 += v[c]; s2 += v[c] * v[c]; }
#pragma unroll
                for (int m = 32; m >= 1; m >>= 1) { s1 += __shfl_xor(s1, m); s2 += __shfl_xor(s2, m); }
                const float mean = s1 * (1.f / 512.f), var = fmaxf(s2 * (1.f / 512.f) - mean * mean, 0.f), rstd = rsqrtf(var + EPS);
                const u32x4 gbr = *(const u32x4*)(GBp + token * 512 + ch0);
                const float gbv[8] = {bf_lo(gbr[0]), bf_hi(gbr[0]), bf_lo(gbr[1]), bf_hi(gbr[1]), bf_lo(gbr[2]), bf_hi(gbr[2]), bf_lo(gbr[3]), bf_hi(gbr[3])};
                float y[8];
#pragma unroll
                for (int c = 0; c < 8; ++c) { const float t = (v[c] - mean) * rstd * lg[c] + lbv[c]; y[c] = siluf_(t) * gbv[c]; }
                u32x4 ob = {cvt_pk_bf16(y[0], y[1]), cvt_pk_bf16(y[2], y[3]), cvt_pk_bf16(y[4], y[5]), cvt_pk_bf16(y[6], y[7])};
                *(u32x4*)(A2 + token * 1024 + 512 + ch0) = ob;
                const u32x4 fo = *(const u32x4*)(O + token * 512 + ch0), bo = *(const u32x4*)(O + ((size_t)NLAT + token) * 512 + ch0);
                float ov[8]; float ss = 0.f;
#pragma unroll
                for (int c = 0; c < 4; ++c) { ov[2 * c] = bf_lo(fo[c]) + bf_lo(bo[c]); ov[2 * c + 1] = bf_hi(fo[c]) + bf_hi(bo[c]); }
#pragma unroll
                for (int c = 0; c < 8; ++c) ss += ov[c] * ov[c];
                ss += __shfl_xor(ss, 1); ss += __shfl_xor(ss, 2); ss += __shfl_xor(ss, 4); ss += __shfl_xor(ss, 8);
                const float rn = rsqrtf(ss * (1.f / 128.f) + EPS);
                const u32x4 gar = *(const u32x4*)(GAp + token * 512 + ch0);
                const float gav[8] = {bf_lo(gar[0]), bf_hi(gar[0]), bf_lo(gar[1]), bf_hi(gar[1]), bf_lo(gar[2]), bf_hi(gar[2]), bf_lo(gar[3]), bf_hi(gar[3])};
                float z[8];
#pragma unroll
                for (int c = 0; c < 8; ++c) z[c] = ov[c] * rn * hg[c] * gav[c];
                u32x4 oa = {cvt_pk_bf16(z[0], z[1]), cvt_pk_bf16(z[2], z[3]), cvt_pk_bf16(z[4], z[5]), cvt_pk_bf16(z[6], z[7])};
                *(u32x4*)(A2 + token * 1024 + ch0) = oa;
            }
    }
}

__device__ void final_phase(const Params& p) {
    const int tid = threadIdx.x, w = tid >> 6, lane = tid & 63;
    const float* modp = (const float*)(p.ws + WS_MODP);
    const bf16_t* Y = (const bf16_t*)(p.ws + WS_QF);
    const int rows_per = NLAT / gridDim.x;
    for (int r0 = blockIdx.x * rows_per; r0 < NLAT; r0 += gridDim.x * rows_per) {
        const int rend = min(r0 + rows_per, NLAT);
        int curb = -1; f32x4 gt[4], g[4];
#pragma unroll
        for (int c = 0; c < 4; ++c) { g[c] = *(const f32x4*)(p.final_norm_g + c * 256 + lane * 4); gt[c] = (f32x4){0.f, 0.f, 0.f, 0.f}; }
        for (int row = r0 + w * 2; row < rend; row += 16) {
            const int b = row >> 12;
            if (b != curb) { curb = b;
#pragma unroll
                for (int c = 0; c < 4; ++c) { f32x4 t = *(const f32x4*)(p.b_mod + 2048 + c * 256 + lane * 4);
#pragma unroll
                    for (int q = 0; q < 4; ++q) t += *(const f32x4*)(modp + (q * 9 + b) * 3072 + 2048 + c * 256 + lane * 4);
                    gt[c] = t; } }
            const float* xp = p.x + (size_t)row * 1024; const bf16_t* yp = Y + (size_t)row * 1024; float* op = p.out + (size_t)row * 1024;
            f32x4 h0[4], h1[4]; float s0 = 0.f, s1 = 0.f;
#pragma unroll
            for (int c = 0; c < 4; ++c) {
                const f32x4 x0 = *(const f32x4*)(xp + c * 256 + lane * 4), x1 = *(const f32x4*)(xp + 1024 + c * 256 + lane * 4);
                const u32x2 y0 = *(const u32x2*)(yp + c * 256 + lane * 4), y1 = *(const u32x2*)(yp + 1024 + c * 256 + lane * 4);
                h0[c] = x0 + gt[c] * (f32x4){bf_lo(y0[0]), bf_hi(y0[0]), bf_lo(y0[1]), bf_hi(y0[1])};
                h1[c] = x1 + gt[c] * (f32x4){bf_lo(y1[0]), bf_hi(y1[0]), bf_lo(y1[1]), bf_hi(y1[1])};
                s0 += h0[c][0] * h0[c][0] + h0[c][1] * h0[c][1] + h0[c][2] * h0[c][2] + h0[c][3] * h0[c][3];
                s1 += h1[c][0] * h1[c][0] + h1[c][1] * h1[c][1] + h1[c][2] * h1[c][2] + h1[c][3] * h1[c][3];
            }
#pragma unroll
            for (int m = 32; m >= 1; m >>= 1) { s0 += __shfl_xor(s0, m); s1 += __shfl_xor(s1, m); }
            const float rs0 = rsqrtf(s0 * (1.f / 1024.f) + EPS), rs1 = rsqrtf(s1 * (1.f / 1024.f) + EPS);
#pragma unroll
            for (int c = 0; c < 4; ++c) { *(f32x4*)(op + c * 256 + lane * 4) = h0[c] * rs0 * g[c]; *(f32x4*)(op + 1024 + c * 256 + lane * 4) = h1[c] * rs1 * g[c]; }
        }
    }
}

__global__ void __launch_bounds__(NTHR, 2) hymba_fwd(Params p) {
    extern __shared__ __attribute__((aligned(16))) unsigned char lds_raw[];
    LAS unsigned char* lds = (LAS unsigned char*)lds_raw;
    const int lo = p.ph_lo, hi = p.ph_hi;
#define IN(k) (lo <= (k) && (k) < hi)
#if N_LAUNCHES == 1
    volatile LAS unsigned* bst = (volatile LAS unsigned*)(lds + 131072);
    if (threadIdx.x < 4) bst[threadIdx.x] = 0u;
    __syncthreads();
    const XcdBarrier bar = xcd_barrier_post((unsigned*)(p.ws + WS_BAR), bst);
#define SEAM(k) do { if (IN(k) && IN((k) + 1)) xcd_barrier(bar); } while (0)
#else
#define SEAM(k) do { } while (0)
#endif
#ifndef DUP_PHASE
#define DUP_PHASE -1
#endif
    if (IN(0)) phase0(lds, p, 0, 192 + 1280);
    SEAM(0);
    if (IN(1)) phase1(lds, p);
    SEAM(1);
    if (IN(2)) {
        pg8::Gemm g{(const bf16_t*)(p.ws + WS_A), (const bf16_t*)(p.ws + WS_WIN), NROWS, 4096, 1024};
        pg8::InOrder S; S.init(NLAT, 4096, gridDim.x, blockIdx.x);
        EpiIn E{p.ws, p.lb_logits};
#pragma unroll 1
        for (int rep = 0; rep < (DUP_PHASE == 2 ? 2 : 1); ++rep) pg8::gemm_phase<EpiIn, pg8::InOrder>(lds, g, S, E);
    }
    SEAM(2);
    if (IN(3)) {
#pragma unroll 1
        for (int rep = 0; rep < (DUP_PHASE == 3 ? 2 : 1); ++rep) scan_phase(lds, p);
    }
    SEAM(3);
    if (IN(4)) { conv_phase(lds, p); if (DUP_PHASE == 4) { __syncthreads(); conv_phase(lds, p); } }
    SEAM(4);
    if (IN(5)) {
        pg8::Gemm g{(const bf16_t*)(p.ws + WS_A), (const bf16_t*)(p.ws + WS_WOUT), NLAT, 1024, 1024};
        pg8::StaticOrder S; S.init(NLAT, 1024, gridDim.x, blockIdx.x);
        EpiOut E{(bf16_t*)(p.ws + WS_QF)};
#pragma unroll 1
        for (int rep = 0; rep < (DUP_PHASE == 5 ? 2 : 1); ++rep) pg8::gemm_phase<EpiOut, pg8::StaticOrder>(lds, g, S, E);
    }
    SEAM(5);
    if (IN(6)) final_phase(p);
}

extern "C" void kernel_launch(void* const* d_in, const int* in_sizes, int n_in, void* d_out, int out_size, void* d_ws, size_t ws_size, hipStream_t stream) {
    static int grid = 0;
    if (grid == 0) {
        int dev = 0, cus = 0, per_cu = 0;
        hipGetDevice(&dev);
        hipDeviceGetAttribute(&cus, hipDeviceAttributeMultiprocessorCount, dev);
        hipFuncSetAttribute((const void*)hymba_fwd, hipFuncAttributeMaxDynamicSharedMemorySize, LDS_BYTES);
        hipOccupancyMaxActiveBlocksPerMultiprocessor(&per_cu, (const void*)hymba_fwd, NTHR, LDS_BYTES);
        if (per_cu < 1) { fprintf(stderr, "kernel_launch: occupancy query says %d blocks/CU\n", per_cu); per_cu = 1; }
        grid = cus * per_cu;
        if (ws_size < WS_END) { fprintf(stderr, "kernel_launch: workspace too small (%zu < %zu)\n", ws_size, (size_t)WS_END); grid = -1; }
    }
    if (grid < 0) return;
    Params p{};
    p.x = (const float*)d_in[0]; p.c = (const float*)d_in[1]; p.ctx = (const float*)d_in[2]; p.c_ctx = (const float*)d_in[3]; p.norm_g = (const float*)d_in[4];
    p.w_mod = (const float*)d_in[5]; p.b_mod = (const float*)d_in[6]; p.w_in = (const float*)d_in[7]; p.lb_logits = (const float*)d_in[8]; p.hgrn_norm_g = (const float*)d_in[9];
    p.conv_w = (const float*)d_in[10]; p.conv_b = (const float*)d_in[11]; p.conv_ln_g = (const float*)d_in[12]; p.conv_ln_b = (const float*)d_in[13]; p.w_out = (const float*)d_in[14];
    p.final_norm_g = (const float*)d_in[15];
    p.out = (float*)d_out; p.ws = (unsigned char*)d_ws;
#if N_LAUNCHES == 1
    p.ph_lo = 0; p.ph_hi = 7;
    hipMemsetAsync((unsigned char*)d_ws + WS_BAR, 0, XCD_BAR_WORDS * 4, stream);
    void* args[] = {&p};
    hipError_t e = hipLaunchCooperativeKernel((const void*)hymba_fwd, dim3(grid), dim3(NTHR), args, LDS_BYTES, stream);
    if (e != hipSuccess) fprintf(stderr, "cooperative launch failed: %s (grid %d)\n", hipGetErrorString(e), grid);
#else
    for (int ph = 0; ph < 7; ++ph) { p.ph_lo = ph; p.ph_hi = ph + 1; hipLaunchKernelGGL(hymba_fwd, dim3(grid), dim3(NTHR), LDS_BYTES, stream, p); }
#endif
}
```

```cpp
#include <hip/hip_runtime.h>
#include <hip/hip_cooperative_groups.h>
#include <cstdio>
namespace cg = cooperative_groups;

#ifndef N_LAUNCHES
#define N_LAUNCHES 1
#endif

#define LAS __attribute__((address_space(3)))
typedef unsigned short bf16_t;
typedef short bf16x8 __attribute__((ext_vector_type(8)));
typedef float f32x4 __attribute__((ext_vector_type(4)));
typedef float f32x2 __attribute__((ext_vector_type(2)));
typedef unsigned u32x4 __attribute__((ext_vector_type(4)));
typedef unsigned u32x2 __attribute__((ext_vector_type(2)));

constexpr int NTHR = 512;
constexpr int DM = 1024, NLAT = 32768, NROWS = 34816;
constexpr int NCHUNK = NROWS / 64;
constexpr float EPS = 1e-6f;
constexpr int LDS_BYTES = 131072 + 16;

constexpr size_t WS_WIN = 0;
constexpr size_t WS_WOUT = 8388608;
constexpr size_t WS_MODP = 10485760;
constexpr size_t WS_RSS = 11010048;
constexpr size_t WS_BAR = 13107200;
constexpr size_t WS_A = 13631488;
constexpr size_t SZ_S = (size_t)NROWS * 512 * 2, SZ_L = (size_t)NLAT * 512 * 2;
constexpr size_t WS_QF = WS_A + (size_t)NROWS * 1024 * 2;
constexpr size_t WS_QB = WS_QF + SZ_S;
constexpr size_t WS_KF = WS_QB + SZ_S;
constexpr size_t WS_KB = WS_KF + SZ_S;
constexpr size_t WS_V = WS_KB + SZ_S;
constexpr size_t WS_GA = WS_V + SZ_S;
constexpr size_t WS_G = WS_GA + SZ_L;
constexpr size_t WS_GB = WS_G + SZ_L;
constexpr size_t WS_RT = WS_GB + SZ_L;
constexpr size_t WS_END = WS_RT + (size_t)2 * 2 * NCHUNK * 512 * 4;

struct Params {
    const float *x, *c, *ctx, *c_ctx, *norm_g, *w_mod, *b_mod, *w_in, *lb_logits, *hgrn_norm_g, *conv_w, *conv_b, *conv_ln_g, *conv_ln_b, *w_out, *final_norm_g;
    float* out; unsigned char* ws; int ph_lo, ph_hi;
};

__device__ __forceinline__ unsigned cvt_pk_bf16(float lo, float hi) { unsigned r; asm volatile("v_cvt_pk_bf16_f32 %0, %1, %2" : "=v"(r) : "v"(lo), "v"(hi)); return r; }
typedef __bf16 bf16x2_t __attribute__((ext_vector_type(2)));
__device__ __forceinline__ unsigned cvt_pk_bf16_mfma(float lo, float hi) { bf16x2_t v = {(__bf16)lo, (__bf16)hi}; return __builtin_bit_cast(unsigned, v); }
__device__ __forceinline__ float bf_lo(unsigned u) { return __uint_as_float(u << 16); }
__device__ __forceinline__ float bf_hi(unsigned u) { return __uint_as_float(u & 0xffff0000u); }
__device__ __forceinline__ float sigmoidf_(float v) { return __builtin_amdgcn_rcpf(1.f + __expf(-v)); }
__device__ __forceinline__ float siluf_(float v) { return v * __builtin_amdgcn_rcpf(1.f + __expf(-v)); }


#define XB_TMO      128
#define XB_XCNT(j)  (256  + 64 * (j))
#define XB_XSUB(j)  (1280 + 64 * (j))
#define XB_XGEN(j)  (2304 + 64 * (j))
#define XB_TOP      3328
#define XB_TOPGEN   3392
#define XCD_BAR_WORDS 3456
#define XB_SPIN_CAP (1u << 18)
__device__ __forceinline__ unsigned xb_ld(unsigned* p)              { return __hip_atomic_load(p, __ATOMIC_RELAXED, __HIP_MEMORY_SCOPE_AGENT); }
__device__ __forceinline__ unsigned xb_add(unsigned* p, unsigned v) { return __hip_atomic_fetch_add(p, v, __ATOMIC_RELAXED, __HIP_MEMORY_SCOPE_AGENT); }
__device__ __forceinline__ unsigned xb_xcc_id() { return (unsigned)__builtin_amdgcn_s_getreg((3 << 11) | 20) & 0xFu; }
#define XB_SPIN(cond, bar) do { unsigned _sp = 0; while (cond) { __builtin_amdgcn_s_sleep(1); \
    if ((++_sp & 255u) == 0u) { if (xb_ld(&(bar)[XB_TMO])) break; if (_sp > XB_SPIN_CAP) { atomicAdd(&(bar)[XB_TMO], 1u); break; } } } } while (0)
struct XcdBarrier { unsigned* bar; unsigned x; volatile LAS unsigned* st; };
__device__ __forceinline__ XcdBarrier xcd_barrier_post(unsigned* bar, volatile LAS unsigned* st) {
    XcdBarrier b; b.bar = bar; b.x = xb_xcc_id(); b.st = st;
    if (threadIdx.x == 0) (void)xb_add(&bar[XB_XCNT(b.x)], 1u);
    return b;
}
__device__ __forceinline__ void xcd_barrier_complete(unsigned* bar, unsigned x, unsigned& nloc, unsigned& nx) {
    const unsigned G = gridDim.x * gridDim.y * gridDim.z;
    unsigned sum, cnt, mine, sp = 0u;
    for (;;) {
        sum = 0u; cnt = 0u; mine = 0u;
#pragma unroll
        for (unsigned j = 0; j < 16; ++j) { const unsigned c = xb_ld(&bar[XB_XCNT(j)]); sum += c; cnt += (c > 0u) ? 1u : 0u; mine = (j == x) ? c : mine; }
        if (sum == G) break;
        __builtin_amdgcn_s_sleep(1);
        if ((++sp & 255u) == 0u) { if (xb_ld(&bar[XB_TMO])) break; if (sp > XB_SPIN_CAP) { atomicAdd(&bar[XB_TMO], 1u); break; } }
    }
    nloc = mine > 0u ? mine : 1u; nx = cnt > 0u ? cnt : 1u;
}
__device__ __forceinline__ void xcd_barrier(const XcdBarrier& b) {
    asm volatile("s_waitcnt vmcnt(0)" ::: "memory");
    __syncthreads();
    if (threadIdx.x == 0) {
        unsigned* bar = b.bar;
        __builtin_amdgcn_s_waitcnt(0);
        unsigned nloc = b.st[0], nx = b.st[1];
        if (nloc == 0u) { xcd_barrier_complete(bar, b.x, nloc, nx); b.st[0] = nloc; b.st[1] = nx; }
        const unsigned old = xb_add(&bar[XB_XSUB(b.x)], 1u);
        const unsigned gen = old / nloc;
        if (old + 1u == (gen + 1u) * nloc) {
            __builtin_amdgcn_fence(__ATOMIC_RELEASE, "agent");
            asm volatile("s_waitcnt vmcnt(0)" ::: "memory");
            const unsigned og = xb_add(&bar[XB_TOP], 1u);
            const unsigned tg = og / nx;
            if (og + 1u == (tg + 1u) * nx) xb_add(&bar[XB_TOPGEN], 1u);
            else XB_SPIN(xb_ld(&bar[XB_TOPGEN]) == tg, bar);
            __builtin_amdgcn_fence(__ATOMIC_ACQUIRE, "agent");
            xb_add(&bar[XB_XGEN(b.x)], 1u);
            asm volatile("s_waitcnt vmcnt(0)" ::: "memory");
        } else {
            XB_SPIN(xb_ld(&bar[XB_XGEN(b.x)]) == gen, bar);
            __builtin_amdgcn_fence(__ATOMIC_ACQUIRE, "agent");
            asm volatile("s_waitcnt vmcnt(0)" ::: "memory");
        }
    }
    __syncthreads();
}

namespace pg8 {
constexpr int BM = 256, BK = 64, HALF = 128, HTB = HALF * BK * 2, STAGE_BYTES = 8 * HTB, NXCD = 8, WGM = 8;
__host__ __device__ __forceinline__ int lds_byte(int r, int c) { const int st = (r >> 4) * 2 + (c >> 5), rr = r & 15, cc = c & 31, ob = rr * 64 + cc * 2; return st * 1024 + (ob ^ (((ob >> 9) & 1) << 5)); }
__host__ __device__ __forceinline__ void stage_rc(int b, int& R, int& C) { const int st = b / 1024, sb = b % 1024, swz = sb ^ (((sb >> 9) & 1) << 5); R = (st >> 1) * 16 + swz / 64; C = (st & 1) * 32 + (swz % 64) / 2; }
__host__ __device__ __forceinline__ int perm32(int rho) { const int n = rho >> 4, i = rho & 15; return 8 * (i >> 2) + 4 * n + (i & 3); }
struct Unit { int pm, pn; };
struct Gemm { const bf16_t* A; const bf16_t* Bt; int M, N, K; };
struct StaticOrder {
    int nM, nN, nwg, G, c;
    __device__ void init(int M, int N, int G_, int c_) { nM = M / BM; nN = N / BM; nwg = nM * nN; G = G_; c = c_; }
    __device__ bool map(int L, Unit& u) const {
        int wgid = L; { const int q = nwg / NXCD, r = nwg % NXCD, xcd = wgid % NXCD, off = wgid / NXCD; wgid = (xcd < r ? xcd * (q + 1) : r * (q + 1) + (xcd - r) * q) + off; }
        const int nig = WGM * nN, gid = wgid / nig, fm = gid * WGM, gsz = (nM - fm) < WGM ? (nM - fm) : WGM;
        u.pm = fm + ((wgid % nig) % gsz); u.pn = (wgid % nig) / gsz; return true;
    }
    __device__ bool next(int i, Unit& u) const { const long L = (long)i * G + c; if (L >= nwg) return false; return map((int)L, u); }
};
struct InOrder : StaticOrder {
    __device__ bool next(int i, Unit& u) const {
        const long L = (long)i * G + c;
        if (L < nwg) return map((int)L, u);
        const int k = (int)(L - nwg); if (k >= 64) return false;
        u.pm = 128 + (k >> 3); u.pn = k & 7; return true;
    }
};

template <class Epi, class Sched>
__device__ __forceinline__ void gemm_phase(LAS unsigned char* lds, const Gemm g, const Sched& S, const Epi& E) {
    const int tid = threadIdx.x, wid = __builtin_amdgcn_readfirstlane(tid >> 6), lane = tid & 63, wr = wid >> 2, wc = wid & 3, fr = lane & 15, fq = lane >> 4;
    const int K = g.K, nt = K / BK;
    unsigned voffA[2], voffB[2];
#pragma unroll
    for (int i = 0; i < 2; ++i) { int R, C; stage_rc(tid * 16 + i * 8192, R, C); const int Rb = Epi::PERM ? ((R & ~31) + perm32(R & 31)) : R;
        voffA[i] = (unsigned)(R * K + C) * 2u; voffB[i] = (unsigned)(Rb * K + C) * 2u; }
    const size_t kstep = (size_t)(BK * 2);
    const size_t hstep = (size_t)HALF * K * 2;
    const size_t tstep = 2 * hstep;
    const unsigned ldsw = (unsigned)wid * 1024u;
    const int aoff = lds_byte(wr * 64 + fr, fq * 8), boff = lds_byte(wc * 32 + fr, fq * 8);
#define PG8_SA(b, h) (((b) * 2 + (h)) * HTB)
#define PG8_SB(b, h) ((4 + (b) * 2 + (h)) * HTB)
#define PG8_STAGE(bufoff, gbase, voff) do { _Pragma("unroll") for (int _i = 0; _i < 2; ++_i) \
        __builtin_amdgcn_global_load_lds((const unsigned*)((const char*)(gbase) + (voff)[_i]), (LAS unsigned*)(lds + (bufoff) + ldsw + _i * 8192), 16, 0, 0); } while (0)
#define PG8_LDA(dst, b, h) do { _Pragma("unroll") for (int m = 0; m < 4; ++m) _Pragma("unroll") for (int k = 0; k < 2; ++k) dst[m][k] = *(const LAS bf16x8*)(lds + PG8_SA(b, h) + aoff + m * 2048 + k * 1024); } while (0)
#define PG8_LDB(dst, b, h) do { _Pragma("unroll") for (int n = 0; n < 2; ++n) _Pragma("unroll") for (int k = 0; k < 2; ++k) dst[n][k] = *(const LAS bf16x8*)(lds + PG8_SB(b, h) + boff + n * 2048 + k * 1024); } while (0)
#define PG8_MMA(ai, bj, At, Bt) do { __builtin_amdgcn_s_setprio(1); _Pragma("unroll") for (int m = 0; m < 4; ++m) _Pragma("unroll") for (int n = 0; n < 2; ++n) _Pragma("unroll") for (int k = 0; k < 2; ++k) \
        acc[ai][bj][m][n] = __builtin_amdgcn_mfma_f32_16x16x32_bf16(Bt[n][k], At[m][k], acc[ai][bj][m][n], 0, 0, 0); __builtin_amdgcn_s_setprio(0); } while (0)
#define PG8_WAIT_V(n) asm volatile("s_waitcnt vmcnt(" #n ")" ::: "memory")
#define PG8_WAIT_L(n) asm volatile("s_waitcnt lgkmcnt(" #n ")" ::: "memory")
#define PG8_BAR __builtin_amdgcn_s_barrier()
#define PG8_SCHED __builtin_amdgcn_sched_barrier(0)
    Unit cur, nxt; int ui = 0;
    if (!S.next(0, cur)) return;
    f32x4 acc[2][2][4][2];
#pragma unroll
    for (int a = 0; a < 2; ++a)
#pragma unroll
        for (int b = 0; b < 2; ++b)
#pragma unroll
            for (int m = 0; m < 4; ++m)
#pragma unroll
                for (int n = 0; n < 2; ++n) acc[a][b][m][n] = (f32x4){0.f, 0.f, 0.f, 0.f};
    bf16x8 At[4][2], B0[2][2], B1[2][2];
    const char* cA = (const char*)g.A + (size_t)cur.pm * tstep; const char* cB = (const char*)g.Bt + (size_t)cur.pn * tstep;
    PG8_STAGE(PG8_SB(0, 0), cB, voffB); PG8_STAGE(PG8_SA(0, 0), cA, voffA); PG8_STAGE(PG8_SB(0, 1), cB + hstep, voffB); PG8_STAGE(PG8_SA(0, 1), cA + hstep, voffA);
    if (wr == 1) PG8_BAR;
    PG8_WAIT_V(4); PG8_BAR;
    PG8_STAGE(PG8_SB(1, 0), cB + kstep, voffB); PG8_STAGE(PG8_SA(1, 0), cA + kstep, voffA); PG8_STAGE(PG8_SB(1, 1), cB + hstep + kstep, voffB);
    PG8_WAIT_V(6); PG8_BAR;
    for (;;) {
        const bool has_next = S.next(ui + 1, nxt);
        const char* nA = has_next ? (const char*)g.A + (size_t)nxt.pm * tstep : cA; const char* nB = has_next ? (const char*)g.Bt + (size_t)nxt.pn * tstep : cB;
        for (int t = 0; t < nt; t += 2) {
            const bool last = (t == nt - 2);
            const char* a1 = cA + (size_t)(t + 1) * kstep;
            const char* a2 = last ? nA : cA + (size_t)(t + 2) * kstep; const char* b2 = last ? nB : cB + (size_t)(t + 2) * kstep;
            const char* a3 = a2 + kstep; const char* b3 = b2 + kstep;
            PG8_LDB(B0, 0, 0); PG8_SCHED; PG8_LDA(At, 0, 0); PG8_STAGE(PG8_SA(1, 1), a1 + hstep, voffA);
            PG8_WAIT_L(8); PG8_BAR; PG8_WAIT_L(0); PG8_MMA(0, 0, At, B0); PG8_BAR; PG8_SCHED;
            PG8_LDB(B1, 0, 1); PG8_STAGE(PG8_SB(0, 0), b2, voffB);
            PG8_BAR; PG8_WAIT_L(0); PG8_MMA(0, 1, At, B1); PG8_BAR;
            PG8_LDA(At, 0, 1); PG8_STAGE(PG8_SA(0, 0), a2, voffA);
            PG8_BAR; PG8_WAIT_L(0); PG8_MMA(1, 0, At, B0); PG8_BAR; PG8_SCHED;
            PG8_STAGE(PG8_SB(0, 1), b2 + hstep, voffB);
            PG8_WAIT_V(6); PG8_BAR; PG8_MMA(1, 1, At, B1); PG8_BAR;
            PG8_LDB(B0, 1, 0); PG8_SCHED; PG8_LDA(At, 1, 0); PG8_STAGE(PG8_SA(0, 1), a2 + hstep, voffA);
            PG8_WAIT_L(8); PG8_BAR; PG8_WAIT_L(0); PG8_MMA(0, 0, At, B0); PG8_BAR; PG8_SCHED;
            PG8_LDB(B1, 1, 1); PG8_STAGE(PG8_SB(1, 0), b3, voffB);
            PG8_BAR; PG8_WAIT_L(0); PG8_MMA(0, 1, At, B1); PG8_BAR;
            PG8_LDA(At, 1, 1); PG8_STAGE(PG8_SA(1, 0), a3, voffA);
            PG8_BAR; PG8_WAIT_L(0); PG8_MMA(1, 0, At, B0); PG8_BAR; PG8_SCHED;
            PG8_STAGE(PG8_SB(1, 1), b3 + hstep, voffB);
            PG8_WAIT_V(6); PG8_BAR; PG8_MMA(1, 1, At, B1); PG8_BAR;
        }
        if (wr == 0) PG8_BAR;
        if (wr == 1) __builtin_amdgcn_s_setprio(1);
        E(acc, cur, wr, wc, fr, fq);
        __builtin_amdgcn_s_setprio(0);
        if (wr == 1) PG8_BAR;
        if (!has_next) break;
#pragma unroll
        for (int a = 0; a < 2; ++a)
#pragma unroll
            for (int b = 0; b < 2; ++b)
#pragma unroll
                for (int m = 0; m < 4; ++m)
#pragma unroll
                    for (int n = 0; n < 2; ++n) acc[a][b][m][n] = (f32x4){0.f, 0.f, 0.f, 0.f};
        cur = nxt; cA = nA; cB = nB; ++ui;
    }
    PG8_WAIT_V(0);
    if (wr == 0) PG8_BAR;
    PG8_BAR;
#undef PG8_SA
#undef PG8_SB
#undef PG8_STAGE
#undef PG8_LDA
#undef PG8_LDB
#undef PG8_MMA
#undef PG8_WAIT_V
#undef PG8_WAIT_L
#undef PG8_BAR
#undef PG8_SCHED
}
}

template <int K> __device__ __forceinline__ float dpp_shr(float x) { return __int_as_float(__builtin_amdgcn_update_dpp(0, __float_as_int(x), 0x110 + K, 0xf, 0xf, true)); }
__device__ __forceinline__ float scan16(float x) { x += dpp_shr<1>(x); x += dpp_shr<2>(x); x += dpp_shr<4>(x); x += dpp_shr<8>(x); return x; }
__device__ __forceinline__ float clamp80(float x) { return fminf(fmaxf(x, -80.f), 80.f); }
struct EpiIn {
    static constexpr bool PERM = true;
    unsigned char* ws; const float* lb_logits;
    __device__ __forceinline__ void operator()(const f32x4 (&acc)[2][2][4][2], const pg8::Unit& u, int wr, int wc, int fr, int fq) const {
        asm volatile("s_nop 15\n\ts_nop 15\n\ts_nop 15\n\ts_nop 15" ::: "memory");
        const int row0 = u.pm * 256 + wr * 64 + fr, pn = u.pn;
        if (pn < 8) {
            bf16_t* QF = (bf16_t*)(ws + WS_QF); bf16_t* QB = (bf16_t*)(ws + WS_QB); bf16_t* KF = (bf16_t*)(ws + WS_KF); bf16_t* KB = (bf16_t*)(ws + WS_KB); bf16_t* V = (bf16_t*)(ws + WS_V);
            float* RT = (float*)(ws + WS_RT);
            const int ch0 = 64 * pn + 16 * wc + 4 * fq;
            float lbF[4], lbB[4];
#pragma unroll
            for (int j = 0; j < 4; ++j) { lbF[j] = 1.f / (1.f + __expf(lb_logits[1024 + ch0 + j] - lb_logits[ch0 + j])); lbB[j] = 1.f / (1.f + __expf(lb_logits[1536 + ch0 + j] - lb_logits[512 + ch0 + j])); }
#pragma unroll
            for (int ai = 0; ai < 2; ++ai) {
                const int rowc = u.pm * 256 + 128 * ai + 64 * wr;
                const int cid = rowc >> 6;
                unsigned oQF[4][2], oQB[4][2], oKF[4][2], oKB[4][2]; f32x4 rtv[4];
#pragma unroll
                for (int jp = 0; jp < 2; ++jp) {
                    float vQF[4][2], vQB[4][2], vKF[4][2], vKB[4][2];
#pragma unroll
                    for (int jj = 0; jj < 2; ++jj) {
                        const int j = 2 * jp + jj;
                        float lfF[4], kkF[4], lfB[4], kkB[4], pF[4], pB[4], tF[4], tB[4];
#pragma unroll
                        for (int m = 0; m < 4; ++m) {
                            { const float z = acc[ai][0][m][1][j]; const float e = __expf(fminf(-z, 30.f)); const float s = __builtin_amdgcn_rcpf(1.f + e); lfF[m] = __logf(lbF[j] + (1.f - lbF[j]) * s); kkF[m] = (1.f - lbF[j]) * e * s; }
                            { const float z = acc[ai][1][m][0][j]; const float e = __expf(fminf(-z, 30.f)); const float s = __builtin_amdgcn_rcpf(1.f + e); lfB[m] = __logf(lbB[j] + (1.f - lbB[j]) * s); kkB[m] = (1.f - lbB[j]) * e * s; }
                            pF[m] = scan16(lfF[m]); pB[m] = scan16(lfB[m]);
                            tF[m] = __int_as_float(__builtin_amdgcn_update_dpp(0, __float_as_int(pF[m]), 0x15F, 0xf, 0xf, true));
                            tB[m] = __int_as_float(__builtin_amdgcn_update_dpp(0, __float_as_int(pB[m]), 0x15F, 0xf, 0xf, true));
                        }
                        const float rF = tF[0] + tF[1], blF = rF + tF[2] + tF[3];
                        const float rB = tB[2] + tB[3], blB = rB + tB[0] + tB[1];
                        float cF = 0.f, cB = 0.f;
#pragma unroll
                        for (int m = 0; m < 4; ++m) {
                            const float bF = pF[m] + cF; cF += tF[m];
                            const float bB = blB - (pB[m] + cB) + lfB[m]; cB += tB[m];
                            const float xF = clamp80(bF - rF), xB = clamp80(bB - rB);
                            const float q = acc[ai][0][m][0][j];
                            vQF[m][jj] = q * __expf(xF); vKF[m][jj] = kkF[m] * __expf(-xF);
                            vQB[m][jj] = q * __expf(xB); vKB[m][jj] = kkB[m] * __expf(-xB);
                        }
                        rtv[0][j] = rF; rtv[1][j] = rB; rtv[2][j] = blF - rF; rtv[3][j] = blB - rB;
                    }
#pragma unroll
                    for (int m = 0; m < 4; ++m) { oQF[m][jp] = cvt_pk_bf16(vQF[m][0], vQF[m][1]); oQB[m][jp] = cvt_pk_bf16(vQB[m][0], vQB[m][1]); oKF[m][jp] = cvt_pk_bf16(vKF[m][0], vKF[m][1]); oKB[m][jp] = cvt_pk_bf16(vKB[m][0], vKB[m][1]); }
                }
                if (fr == 0) {
#pragma unroll
                    for (int t = 0; t < 4; ++t) *(f32x4*)(RT + (size_t)t * NCHUNK * 512 + (size_t)cid * 512 + ch0) = rtv[t];
                }
#pragma unroll
                for (int mp = 0; mp < 2; ++mp) {
                    const int a = 2 * mp, bb = 2 * mp + 1, odd = fq & 1;
                    const size_t off = (size_t)(rowc + 16 * (odd ? bb : a) + fr) * 512 + (ch0 - 4 * odd);
                    const f32x4 va = acc[ai][1][a][1], vb = acc[ai][1][bb][1];
                    const unsigned oVa0 = cvt_pk_bf16(va[0], va[1]), oVa1 = cvt_pk_bf16(va[2], va[3]), oVb0 = cvt_pk_bf16(vb[0], vb[1]), oVb1 = cvt_pk_bf16(vb[2], vb[3]);
                    asm volatile("s_nop 1" ::: "memory");
#define WIDE_ST(P, x0a, x1a, x0b, x1b) do { const u32x2 s0 = __builtin_amdgcn_permlane16_swap((x0a), (x0b), false, false), s1 = __builtin_amdgcn_permlane16_swap((x1a), (x1b), false, false); \
                        *(u32x4*)((P) + off) = (u32x4){s0[0], s1[0], s0[1], s1[1]}; } while (0)
                    WIDE_ST(QF, oQF[a][0], oQF[a][1], oQF[bb][0], oQF[bb][1]); WIDE_ST(QB, oQB[a][0], oQB[a][1], oQB[bb][0], oQB[bb][1]);
                    WIDE_ST(KF, oKF[a][0], oKF[a][1], oKF[bb][0], oKF[bb][1]); WIDE_ST(KB, oKB[a][0], oKB[a][1], oKB[bb][0], oKB[bb][1]);
                    WIDE_ST(V, oVa0, oVa1, oVb0, oVb1);
#undef WIDE_ST
                }
            }
        } else if (pn >= 10 && pn <= 13) {
            bf16_t* G = (bf16_t*)(ws + WS_G);
            const int chb = 128 * (pn - 10) + 16 * wc + 4 * fq;
            const int odd = fq & 1;
#pragma unroll
            for (int ai = 0; ai < 2; ++ai)
#pragma unroll
                for (int mp = 0; mp < 2; ++mp) {
                    const size_t row = (size_t)(row0 + ai * 128 + (2 * mp + odd) * 16);
#pragma unroll
                    for (int bj = 0; bj < 2; ++bj) {
                        const f32x4 ua = acc[ai][bj][2 * mp][0], ga = acc[ai][bj][2 * mp][1], ub = acc[ai][bj][2 * mp + 1][0], gb = acc[ai][bj][2 * mp + 1][1];
                        const unsigned a0 = cvt_pk_bf16(ua[0] * sigmoidf_(ga[0]), ua[1] * sigmoidf_(ga[1])), a1 = cvt_pk_bf16(ua[2] * sigmoidf_(ga[2]), ua[3] * sigmoidf_(ga[3]));
                        const unsigned b0 = cvt_pk_bf16(ub[0] * sigmoidf_(gb[0]), ub[1] * sigmoidf_(gb[1])), b1 = cvt_pk_bf16(ub[2] * sigmoidf_(gb[2]), ub[3] * sigmoidf_(gb[3]));
                        asm volatile("s_nop 1" ::: "memory");
                        const u32x2 s0 = __builtin_amdgcn_permlane16_swap(a0, b0, false, false), s1 = __builtin_amdgcn_permlane16_swap(a1, b1, false, false);
                        *(u32x4*)(G + row * 512 + (chb - 4 * odd) + 64 * bj) = (u32x4){s0[0], s1[0], s0[1], s1[1]};
                    }
                }
        } else {
            bf16_t* D = (bf16_t*)(ws + (pn < 10 ? WS_GA : WS_GB));
            const int colb = 256 * (pn < 10 ? pn - 8 : pn - 14) + 32 * wc + 8 * fq;
#pragma unroll
            for (int ai = 0; ai < 2; ++ai)
#pragma unroll
                for (int m = 0; m < 4; ++m) {
                    const size_t row = (size_t)(row0 + ai * 128 + m * 16);
#pragma unroll
                    for (int bj = 0; bj < 2; ++bj) {
                        f32x4 v0 = acc[ai][bj][m][0], v1 = acc[ai][bj][m][1];
#pragma unroll
                        for (int j = 0; j < 4; ++j) { v0[j] = siluf_(v0[j]); v1[j] = siluf_(v1[j]); }
                        u32x4 o = {cvt_pk_bf16(v0[0], v0[1]), cvt_pk_bf16(v0[2], v0[3]), cvt_pk_bf16(v1[0], v1[1]), cvt_pk_bf16(v1[2], v1[3])};
                        *(u32x4*)(D + row * 512 + colb + 128 * bj) = o;
                    }
                }
        }
    }
};

struct EpiOut {
    static constexpr bool PERM = true;
    bf16_t* Y;
    __device__ __forceinline__ void operator()(const f32x4 (&acc)[2][2][4][2], const pg8::Unit& u, int wr, int wc, int fr, int fq) const {
        asm volatile("s_nop 15\n\ts_nop 15\n\ts_nop 15\n\ts_nop 15" ::: "memory");
        const int row0 = u.pm * 256 + wr * 64 + fr, col0 = u.pn * 256 + wc * 32 + 8 * fq;
#pragma unroll
        for (int ai = 0; ai < 2; ++ai)
#pragma unroll
            for (int m = 0; m < 4; ++m) {
                const size_t row = (size_t)(row0 + ai * 128 + m * 16);
#pragma unroll
                for (int bj = 0; bj < 2; ++bj) {
                    const f32x4 v0 = acc[ai][bj][m][0], v1 = acc[ai][bj][m][1];
                    u32x4 o = {cvt_pk_bf16(v0[0], v0[1]), cvt_pk_bf16(v0[2], v0[3]), cvt_pk_bf16(v1[0], v1[1]), cvt_pk_bf16(v1[2], v1[3])};
                    *(u32x4*)(Y + row * 1024 + col0 + 128 * bj) = o;
                }
            }
    }
};

__device__ void phase0(LAS unsigned char* lds, const Params& p, int it_lo, int it_hi) {
    const int tid = threadIdx.x;
    LAS float* fl = (LAS float*)lds;
    float* modp = (float*)(p.ws + WS_MODP);
    for (int it = it_lo + blockIdx.x; it < it_hi; it += gridDim.x) {
        if (it < 192) {
            const int cc = it % 48, kq = it / 48;
            LAS float* sil = fl; LAS float* red = fl + 2304;
            for (int i = tid; i < 2304; i += NTHR) { const int j = i >> 8, k = kq * 256 + (i & 255); const float v = (j < 8) ? p.c[j * 1024 + k] : p.c_ctx[k]; sil[i] = siluf_(v); }
            __syncthreads();
            const int n = tid & 63, ks = tid >> 6;
            const float* wp = p.w_mod + (size_t)(kq * 256 + ks * 32) * 3072 + cc * 64 + n;
            float a[9];
#pragma unroll
            for (int j = 0; j < 9; ++j) a[j] = 0.f;
#pragma unroll 8
            for (int kk = 0; kk < 32; ++kk) { const float w = wp[(size_t)kk * 3072];
#pragma unroll
                for (int j = 0; j < 9; ++j) a[j] += sil[j * 256 + ks * 32 + kk] * w; }
#pragma unroll
            for (int j = 0; j < 9; ++j) red[(ks * 9 + j) * 64 + n] = a[j];
            __syncthreads();
            for (int i = tid; i < 576; i += NTHR) { const int j = i >> 6, nn = i & 63; float s = 0.f;
#pragma unroll
                for (int k2 = 0; k2 < 8; ++k2) s += red[(k2 * 9 + j) * 64 + nn];
                modp[(kq * 9 + j) * 3072 + cc * 64 + nn] = s; }
            __syncthreads();
        } else {
            int t = it - 192; const float* W; bf16_t* WT; int N; bool isin;
            if (t < 1024) { W = p.w_in; WT = (bf16_t*)(p.ws + WS_WIN); N = 4096; isin = true; } else { t -= 1024; W = p.w_out; WT = (bf16_t*)(p.ws + WS_WOUT); N = 1024; isin = false; }
            const int kt = t & 15, nt = t >> 4;
            const int n = tid & 63, k0 = tid >> 6;
            const int ncol = nt * 64 + n; int src = ncol;
            if (isin && ncol < 2048) { const int pnn = ncol >> 8, cc = ncol & 255; const int type = ((cc >> 7) << 1) | ((cc >> 2) & 1); src = type * 512 + 64 * pnn + 16 * ((cc >> 5) & 3) + 4 * ((cc >> 3) & 3) + (cc & 3); }
            else if (isin && ncol >= 2560 && ncol < 3584) { const int mm = ncol - 2560, g = mm >> 3, i = mm & 7; src = (i < 4) ? 2560 + 4 * g + i : 3072 + 4 * g + (i - 4); }
#pragma unroll
            for (int ps = 0; ps < 8; ++ps) { const int k = ps * 8 + k0; fl[k * 65 + n] = W[(size_t)(kt * 64 + k) * N + src]; }
            __syncthreads();
            const int nn = tid >> 3, k8 = tid & 7;
            float v[8];
#pragma unroll
            for (int j = 0; j < 8; ++j) v[j] = fl[(k8 * 8 + j) * 65 + nn];
            u32x4 o = {cvt_pk_bf16(v[0], v[1]), cvt_pk_bf16(v[2], v[3]), cvt_pk_bf16(v[4], v[5]), cvt_pk_bf16(v[6], v[7])};
            *(u32x4*)(WT + (size_t)(nt * 64 + nn) * 1024 + kt * 64 + k8 * 8) = o;
            __syncthreads();
        }
    }
}

__device__ void phase1(LAS unsigned char* lds, const Params& p) {
    const int tid = threadIdx.x, w = tid >> 6, lane = tid & 63;
    LAS float* mv = (LAS float*)lds;
    const float* modp = (const float*)(p.ws + WS_MODP);
    bf16_t* A = (bf16_t*)(p.ws + WS_A);
    const int ngrp = NROWS / 8;
    const int g0 = (int)((long)blockIdx.x * ngrp / gridDim.x), g1 = (int)((long)(blockIdx.x + 1) * ngrp / gridDim.x);
    int curj = -1;
    for (int g = g0; g < g1; ++g) {
        const int row0 = g * 8; const int j = row0 < NLAT ? (row0 >> 12) : 8;
        if (j != curj) {
            __syncthreads();
            for (int i = tid; i < 1024; i += NTHR) { float sh = p.b_mod[i], sc = p.b_mod[1024 + i];
#pragma unroll
                for (int q = 0; q < 4; ++q) { sh += modp[(q * 9 + j) * 3072 + i]; sc += modp[(q * 9 + j) * 3072 + 1024 + i]; }
                mv[i] = p.norm_g[i] * (1.f + sc); mv[1024 + i] = sh; }
            __syncthreads(); curj = j;
        }
        const int row = row0 + w;
        const float* xr = row < NLAT ? p.x + (size_t)row * 1024 : p.ctx + (size_t)(row - NLAT) * 1024;
        f32x4 v[4]; float ss = 0.f;
#pragma unroll
        for (int c = 0; c < 4; ++c) { v[c] = *(const f32x4*)(xr + c * 256 + lane * 4); ss += v[c][0] * v[c][0] + v[c][1] * v[c][1] + v[c][2] * v[c][2] + v[c][3] * v[c][3]; }
#pragma unroll
        for (int m = 32; m >= 1; m >>= 1) ss += __shfl_xor(ss, m);
        const float rs = rsqrtf(ss * (1.f / 1024.f) + EPS);
#pragma unroll
        for (int c = 0; c < 4; ++c) { const int k = c * 256 + lane * 4; const f32x4 m0 = *(const LAS f32x4*)(mv + k), m1 = *(const LAS f32x4*)(mv + 1024 + k);
            const f32x4 a = v[c] * rs * m0 + m1; u32x2 o = {cvt_pk_bf16(a[0], a[1]), cvt_pk_bf16(a[2], a[3])}; *(u32x2*)(A + (size_t)row * 1024 + k) = o; }
    }
}

#define MFMA16(a, b, c) __builtin_amdgcn_mfma_f32_16x16x32_bf16((a), (b), (c), 0, 0, 0)
__device__ __forceinline__ int scan_cid(int n, int dir, int b) { return n < 4 ? 512 + b * 4 + (dir ? 3 - n : n) : b * 64 + (dir ? 67 - n : n - 4); }
#define SCAN_BAR() asm volatile("s_waitcnt lgkmcnt(0)\n\ts_barrier" ::: "memory")
#define SB_() __builtin_amdgcn_sched_barrier(0)
typedef short s16x4 __attribute__((ext_vector_type(4)));
__device__ __forceinline__ bf16x8 tr_pair(const LAS bf16_t* img, int stride, int r0a, int r0b, int c0, int ln) {
    const int q = ln >> 2, p = ln & 3;
    const s16x4 a = __builtin_amdgcn_ds_read_tr16_b64_v4i16((LAS s16x4*)(img + (r0a + q) * stride + c0 + 4 * p));
    const s16x4 b = __builtin_amdgcn_ds_read_tr16_b64_v4i16((LAS s16x4*)(img + (r0b + q) * stride + c0 + 4 * p));
    return __builtin_shufflevector(a, b, 0, 1, 2, 3, 4, 5, 6, 7);
}
__device__ void scan_phase(LAS unsigned char* lds, const Params& p) {
    const int tid = threadIdx.x, w = __builtin_amdgcn_readfirstlane(tid >> 6), lane = tid & 63, ln = lane & 15, lq = lane >> 4;
    constexpr int QST = 136, VST = 36;
    constexpr int OFF_KS = 17408, OFF_V = 34816, BUFB = 39424;
    LAS bf16_t* Sr = (LAS bf16_t*)(lds + 2 * BUFB);
    LAS float* scs = (LAS float*)(lds + 2 * BUFB + 9216);
    bf16_t* O = (bf16_t*)p.out;
    bf16_t* Odummy = (bf16_t*)(p.ws + WS_A) + (size_t)blockIdx.x * 64 * 512;
    const float* RT = (const float*)(p.ws + WS_RT);
    const int eb = w & 1, tb = w >> 1;
    if (w >= 4) __builtin_amdgcn_s_setprio(1);
    for (int item = blockIdx.x; item < 256; item += gridDim.x) {
        const int seq = (item & 7) + 8 * (item >> 5), es = (item >> 3) & 3;
        const int dir = seq & 1, h = (seq >> 1) & 3, b = seq >> 3;
        const char* Qx = (const char*)((const bf16_t*)(p.ws + (dir ? WS_QB : WS_QF)) + h * 128);
        const char* Kx = (const char*)((const bf16_t*)(p.ws + (dir ? WS_KB : WS_KF)) + h * 128);
        const char* Vx = (const char*)((const bf16_t*)(p.ws + WS_V) + h * 128 + es * 32);
        const char* Rx = (const char*)(RT + (size_t)dir * NCHUNK * 512 + h * 128);
        const char* Tx = (const char*)(RT + (size_t)(2 + dir) * NCHUNK * 512 + h * 128);
        const unsigned qoff0 = (unsigned)((dir ? 63 - (tid >> 4) : (tid >> 4)) * 1024 + (tid & 15) * 16), qstep = dir ? (unsigned)-32768 : 32768u;
        const unsigned voff = (unsigned)((dir ? 63 - (tid >> 3) : (tid >> 3)) * 1024 + (tid & 7) * 8), roff = (unsigned)(tid & 127) * 4u;
        f32x4 S[2] = {(f32x4){0.f, 0.f, 0.f, 0.f}, (f32x4){0.f, 0.f, 0.f, 0.f}};
        float tailp = 0.f;
        u32x4 k4A[2], k4B[2], k4C[2], k4D[2]; u32x4 q4A[2], q4B[2], q4C[2], q4D[2]; u32x2 v4A, v4B, v4C, v4D; float rvA, tlA, rvB, tlB, rvC, tlC, rvD, tlD;
#define SCAN_LOAD(n, k4, q4, v4, rv, tl) do { const size_t cb_ = (size_t)scan_cid((n), dir, b) * 65536; const size_t rb_ = (size_t)scan_cid((n), dir, b) * 2048; SB_(); \
            _Pragma("unroll") for (int i = 0; i < 2; ++i) { k4[i] = *(const u32x4*)(Kx + cb_ + (qoff0 + (unsigned)i * qstep)); SB_(); } \
            _Pragma("unroll") for (int i = 0; i < 2; ++i) { q4[i] = *(const u32x4*)(Qx + cb_ + (qoff0 + (unsigned)i * qstep)); SB_(); } \
            v4 = *(const u32x2*)(Vx + cb_ + voff); SB_(); rv = *(const float*)(Rx + rb_ + roff); SB_(); tl = *(const float*)(Tx + rb_ + roff); SB_(); } while (0)
#define SCAN_STAGE(bf, k4, q4, v4, rv, tl) do { LAS unsigned char* B_ = lds + (bf) * BUFB; \
            _Pragma("unroll") for (int i = 0; i < 2; ++i) { const int pc = tid + 512 * i; *(LAS u32x4*)(B_ + ((pc >> 4) * QST + (pc & 15) * 8) * 2) = q4[i]; *(LAS u32x4*)(B_ + OFF_KS + ((pc >> 4) * QST + (pc & 15) * 8) * 2) = k4[i]; } \
            *(LAS u32x2*)(B_ + OFF_V + ((tid >> 3) * VST + (tid & 7) * 4) * 2) = v4; \
            if (tid < 128) { scs[(bf) * 128 + tid] = __expf(rv + tailp); tailp = tl; } } while (0)
#define SCAN_MAT(bf, n) do { LAS unsigned char* B_ = lds + (bf) * BUFB; LAS bf16_t* Qs = (LAS bf16_t*)B_; LAS bf16_t* Ks = (LAS bf16_t*)(B_ + OFF_KS); LAS bf16_t* Vs = (LAS bf16_t*)(B_ + OFF_V); \
            _Pragma("unroll") for (int ti = 0; ti < 2; ++ti) { const int db = 2 * tb + ti; const float scv = scs[(bf) * 128 + 16 * db + ln]; S[ti] *= scv; \
                *(LAS u32x2*)(Sr + (16 * db + ln) * VST + 16 * eb + 4 * lq) = (u32x2){cvt_pk_bf16(S[ti][0], S[ti][1]), cvt_pk_bf16(S[ti][2], S[ti][3])}; } \
            bf16x8 Bq[4]; f32x4 pt[4]; \
            _Pragma("unroll") for (int ks = 0; ks < 4; ++ks) Bq[ks] = *(const LAS bf16x8*)(Qs + (16 * tb + ln) * QST + ks * 32 + lq * 8); \
            _Pragma("unroll") for (int sb = 0; sb < 4; ++sb) { pt[sb] = (f32x4){0.f, 0.f, 0.f, 0.f}; \
                if (sb <= tb) { f32x4 a = (f32x4){0.f, 0.f, 0.f, 0.f}; \
                    _Pragma("unroll") for (int ks = 0; ks < 4; ++ks) { const bf16x8 Ak = *(const LAS bf16x8*)(Ks + (16 * sb + ln) * QST + ks * 32 + lq * 8); a = MFMA16(Ak, Bq[ks], a); } \
                    if (sb == tb) { _Pragma("unroll") for (int i = 0; i < 4; ++i) if (4 * lq + i > ln) a[i] = 0.f; } \
                    pt[sb] = a; } } \
            SCAN_BAR(); \
            f32x4 o = (f32x4){0.f, 0.f, 0.f, 0.f}; \
            _Pragma("unroll") for (int ks = 0; ks < 4; ++ks) { const bf16x8 As = tr_pair(Sr, VST, 32 * ks + 8 * lq, 32 * ks + 8 * lq + 4, 16 * eb, ln); o = MFMA16(As, Bq[ks], o); } \
            _Pragma("unroll") for (int g = 0; g < 2; ++g) { if (2 * g <= tb) { \
                    const bf16x8 Av = tr_pair(Vs, VST, 32 * g + 4 * lq, 32 * g + 16 + 4 * lq, 16 * eb, ln); \
                    const u32x4 bp = {cvt_pk_bf16_mfma(pt[2 * g][0], pt[2 * g][1]), cvt_pk_bf16(pt[2 * g][2], pt[2 * g][3]), cvt_pk_bf16(pt[2 * g + 1][0], pt[2 * g + 1][1]), cvt_pk_bf16(pt[2 * g + 1][2], pt[2 * g + 1][3])}; \
                    o = MFMA16(Av, __builtin_bit_cast(bf16x8, bp), o); } } \
            { const int pos = 16 * tb + ln; const size_t row = (size_t)scan_cid((n), dir, b) * 64 + (dir ? 63 - pos : pos); \
              bf16_t* dst = ((n) >= 4) ? O + ((size_t)dir * NLAT + row) * 512 + h * 128 + es * 32 : Odummy + (size_t)pos * 512;     \
              *(u32x2*)(dst + 16 * eb + 4 * lq) = (u32x2){cvt_pk_bf16_mfma(o[0], o[1]), cvt_pk_bf16_mfma(o[2], o[3])}; } \
            _Pragma("unroll") for (int k2i = 0; k2i < 2; ++k2i) { const bf16x8 Av = tr_pair(Vs, VST, 32 * k2i + 8 * lq, 32 * k2i + 8 * lq + 4, 16 * eb, ln); \
                _Pragma("unroll") for (int ti = 0; ti < 2; ++ti) { const bf16x8 Bk = tr_pair(Ks, QST, 32 * k2i + 8 * lq, 32 * k2i + 8 * lq + 4, 16 * (2 * tb + ti), ln); S[ti] = MFMA16(Av, Bk, S[ti]); } } \
            } while (0)
        SCAN_LOAD(0, k4A, q4A, v4A, rvA, tlA); SCAN_LOAD(1, k4B, q4B, v4B, rvB, tlB); SCAN_LOAD(2, k4C, q4C, v4C, rvC, tlC); SCAN_LOAD(3, k4D, q4D, v4D, rvD, tlD);
        SCAN_STAGE(0, k4A, q4A, v4A, rvA, tlA); SCAN_LOAD(4, k4A, q4A, v4A, rvA, tlA);
        SCAN_BAR();
#pragma unroll 1
        for (int n0 = 0; n0 < 68; n0 += 4) {
            SCAN_STAGE(1, k4B, q4B, v4B, rvB, tlB); SCAN_LOAD(min(n0 + 5, 67), k4B, q4B, v4B, rvB, tlB); SCAN_MAT(0, n0); SCAN_BAR();
            SCAN_STAGE(0, k4C, q4C, v4C, rvC, tlC); SCAN_LOAD(min(n0 + 6, 67), k4C, q4C, v4C, rvC, tlC); SCAN_MAT(1, n0 + 1); SCAN_BAR();
            SCAN_STAGE(1, k4D, q4D, v4D, rvD, tlD); SCAN_LOAD(min(n0 + 7, 67), k4D, q4D, v4D, rvD, tlD); SCAN_MAT(0, n0 + 2); SCAN_BAR();
            SCAN_STAGE(0, k4A, q4A, v4A, rvA, tlA); SCAN_LOAD(min(n0 + 8, 67), k4A, q4A, v4A, rvA, tlA); SCAN_MAT(1, n0 + 3); SCAN_BAR();
        }
#undef SCAN_LOAD
#undef SCAN_STAGE
#undef SCAN_MAT
    }
    __builtin_amdgcn_s_setprio(0);
}

__device__ void conv_phase(LAS unsigned char* lds, const Params& p) {
    const int tid = threadIdx.x, w = tid >> 6, lane = tid & 63;
    LAS float* wl = (LAS float*)lds;
    for (int i = tid; i < 32 * 128; i += NTHR) ((LAS f32x4*)wl)[i] = (i < 31 * 128) ? ((const f32x4*)p.conv_w)[i] : (f32x4){0.f, 0.f, 0.f, 0.f};
    __syncthreads();
    const bf16_t* Gp = (const bf16_t*)(p.ws + WS_G); const bf16_t* GAp = (const bf16_t*)(p.ws + WS_GA); const bf16_t* GBp = (const bf16_t*)(p.ws + WS_GB);
    const bf16_t* O = (const bf16_t*)p.out;
    bf16_t* A2 = (bf16_t*)(p.ws + WS_A);
    const int half = lane >> 5, ch0 = lane * 8;
    for (int it = blockIdx.x * 8 + w; it < 8192; it += gridDim.x * 8) {
        const int b = it >> 10, r0 = ((it >> 5) & 31) * 2, c0 = (it & 31) * 2;
        float acc[4][8];
        const char* Pb = (const char*)Gp;
        const int base = half ? r0 : c0;
        const unsigned stepB = (half ? 64u : 1u) * 1024u;
#pragma unroll 1
        for (int line = 0; line < 2; ++line) {
            const int tok0 = half ? (c0 + line) : (r0 + line) * 64;
            const unsigned offb = (unsigned)((b * 4096 + tok0) * 512 + ch0) * 2u;
            asm volatile("" ::: "memory");
            float cur[2][8];
#pragma unroll
            for (int a = 0; a < 2; ++a)
#pragma unroll
                for (int c = 0; c < 8; ++c) cur[a][c] = 0.f;
            float Wp[8];
#pragma unroll
            for (int c = 0; c < 8; ++c) Wp[c] = 0.f;
#pragma unroll 1
            for (int hb = 0; hb < 4; ++hb) {
                u32x4 raw[8];
#pragma unroll
                for (int q = 0; q < 8; ++q) {
                    const int xx = base - 15 + hb * 8 + q;
                    const int xc = min(max(xx, 0), 63);
                    const u32x4 r = *(const u32x4*)(Pb + (offb + (unsigned)xc * stepB));
                    const bool ok = (xx == xc);
                    raw[q] = (u32x4){ok ? r[0] : 0u, ok ? r[1] : 0u, ok ? r[2] : 0u, ok ? r[3] : 0u};
                }
                const LAS float* wrow = wl + hb * 8 * 512 + ch0;
#pragma unroll
                for (int q = 0; q < 8; ++q) {
                    const float in[8] = {bf_lo(raw[q][0]), bf_hi(raw[q][0]), bf_lo(raw[q][1]), bf_hi(raw[q][1]), bf_lo(raw[q][2]), bf_hi(raw[q][2]), bf_lo(raw[q][3]), bf_hi(raw[q][3])};
                    const f32x4 wa = *(const LAS f32x4*)(wrow + q * 512), wb = *(const LAS f32x4*)(wrow + q * 512 + 4);
                    const float Wc[8] = {wa[0], wa[1], wa[2], wa[3], wb[0], wb[1], wb[2], wb[3]};
#pragma unroll
                    for (int c = 0; c < 8; ++c) { cur[0][c] += Wc[c] * in[c]; cur[1][c] += Wp[c] * in[c]; Wp[c] = Wc[c]; }
                }
            }
#pragma unroll
            for (int j = 0; j < 2; ++j)
#pragma unroll
                for (int c = 0; c < 8; ++c) { if (line == 0) acc[j][c] = cur[j][c]; else acc[2 + j][c] = cur[j][c]; }
        }
        float cbv[8], lg[8], lbv[8], hg[8];
        { const f32x4 a0 = *(const f32x4*)(p.conv_b + ch0), a1 = *(const f32x4*)(p.conv_b + ch0 + 4), b0 = *(const f32x4*)(p.conv_ln_g + ch0), b1 = *(const f32x4*)(p.conv_ln_g + ch0 + 4);
          const f32x4 d0 = *(const f32x4*)(p.conv_ln_b + ch0), d1 = *(const f32x4*)(p.conv_ln_b + ch0 + 4), e0 = *(const f32x4*)(p.hgrn_norm_g + ch0), e1 = *(const f32x4*)(p.hgrn_norm_g + ch0 + 4);
#pragma unroll
          for (int c = 0; c < 4; ++c) { cbv[c] = a0[c]; cbv[4 + c] = a1[c]; lg[c] = b0[c]; lg[4 + c] = b1[c]; lbv[c] = d0[c]; lbv[4 + c] = d1[c]; hg[c] = e0[c]; hg[4 + c] = e1[c]; } }
#pragma unroll
        for (int lr = 0; lr < 2; ++lr)
#pragma unroll
            for (int lc = 0; lc < 2; ++lc) {
                const size_t token = (size_t)b * 4096 + (r0 + lr) * 64 + (c0 + lc);
                float v[8]; float s1 = 0.f, s2 = 0.f;
#pragma unroll
                for (int c = 0; c < 8; ++c) { v[c] = (half ? acc[lc * 2 + lr][c] : acc[lr * 2 + lc][c]) + cbv[c]; s1 += v[c]; s2 += v[c] * v[c]; }
#pragma unroll
                for (int m = 32; m >= 1; m >>= 1) { s1 += __shfl_xor(s1, m); s2 += __shfl_xor(s2, m); }
                const float mean = s1 * (1.f / 512.f), var = fmaxf(s2 * (1.f / 512.f) - mean * mean, 0.f), rstd = rsqrtf(var + EPS);
                const u32x4 gbr = *(const u32x4*)(GBp + token * 512 + ch0);
                const float gbv[8] = {bf_lo(gbr[0]), bf_hi(gbr[0]), bf_lo(gbr[1]), bf_hi(gbr[1]), bf_lo(gbr[2]), bf_hi(gbr[2]), bf_lo(gbr[3]), bf_hi(gbr[3])};
                float y[8];
#pragma unroll
                for (int c = 0; c < 8; ++c) { const float t = (v[c] - mean) * rstd * lg[c] + lbv[c]; y[c] = siluf_(t) * gbv[c]; }
                u32x4 ob = {cvt_pk_bf16(y[0], y[1]), cvt_pk_bf16(y[2], y[3]), cvt_pk_bf16(y[4], y[5]), cvt_pk_bf16(y[6], y[7])};
                *(u32x4*)(A2 + token * 1024 + 512 + ch0) = ob;
                const u32x4 fo = *(const u32x4*)(O + token * 512 + ch0), bo = *(const u32x4*)(O + ((size_t)NLAT + token) * 512 + ch0);
                float ov[8]; float ss = 0.f;
#pragma unroll
                for (int c = 0; c < 4; ++c) { ov[2 * c] = bf_lo(fo[c]) + bf_lo(bo[c]); ov[2 * c + 1] = bf_hi(fo[c]) + bf_hi(bo[c]); }
#pragma unroll
                for (int c = 0; c < 8; ++c) ss += ov[c] * ov[c];
                ss += __shfl_xor(ss, 1); ss += __shfl_xor(ss, 2); ss += __shfl_xor(ss, 4); ss += __shfl_xor(ss, 8);
                const float rn = rsqrtf(ss * (1.f / 128.f) + EPS);
                const u32x4 gar = *(const u32x4*)(GAp + token * 512 + ch0);
                const float gav[8] = {bf_lo(gar[0]), bf_hi(gar[0]), bf_lo(gar[1]), bf_hi(gar[1]), bf_lo(gar[2]), bf_hi(gar[2]), bf_lo(gar[3]), bf_hi(gar[3])};
                float z[8];
#pragma unroll
                for (int c = 0; c < 8; ++c) z[c] = ov[c] * rn * hg[c] * gav[c];
                u32x4 oa = {cvt_pk_bf16(z[0], z[1]), cvt_pk_bf16(z[2], z[3]), cvt_pk_bf16(z[4], z[5]), cvt_pk_bf16(z[6], z[7])};
                *(u32x4*)(A2 + token * 1024 + ch0) = oa;
            }
    }
}

__device__ void final_phase(const Params& p) {
    const int tid = threadIdx.x, w = tid >> 6, lane = tid & 63;
    const float* modp = (const float*)(p.ws + WS_MODP);
    const bf16_t* Y = (const bf16_t*)(p.ws + WS_QF);
    const int rows_per = NLAT / gridDim.x;
    for (int r0 = blockIdx.x * rows_per; r0 < NLAT; r0 += gridDim.x * rows_per) {
        const int rend = min(r0 + rows_per, NLAT);
        int curb = -1; f32x4 gt[4], g[4];
#pragma unroll
        for (int c = 0; c < 4; ++c) { g[c] = *(const f32x4*)(p.final_norm_g + c * 256 + lane * 4); gt[c] = (f32x4){0.f, 0.f, 0.f, 0.f}; }
        for (int row = r0 + w * 2; row < rend; row += 16) {
            const int b = row >> 12;
            if (b != curb) { curb = b;
#pragma unroll
                for (int c = 0; c < 4; ++c) { f32x4 t = *(const f32x4*)(p.b_mod + 2048 + c * 256 + lane * 4);
#pragma unroll
                    for (int q = 0; q < 4; ++q) t += *(const f32x4*)(modp + (q * 9 + b) * 3072 + 2048 + c * 256 + lane * 4);
                    gt[c] = t; } }
            const float* xp = p.x + (size_t)row * 1024; const bf16_t* yp = Y + (size_t)row * 1024; float* op = p.out + (size_t)row * 1024;
            f32x4 h0[4], h1[4]; float s0 = 0.f, s1 = 0.f;
#pragma unroll
            for (int c = 0; c < 4; ++c) {
                const f32x4 x0 = *(const f32x4*)(xp + c * 256 + lane * 4), x1 = *(const f32x4*)(xp + 1024 + c * 256 + lane * 4);
                const u32x2 y0 = *(const u32x2*)(yp + c * 256 + lane * 4), y1 = *(const u32x2*)(yp + 1024 + c * 256 + lane * 4);
                h0[c] = x0 + gt[c] * (f32x4){bf_lo(y0[0]), bf_hi(y0[0]), bf_lo(y0[1]), bf_hi(y0[1])};
                h1[c] = x1 + gt[c] * (f32x4){bf_lo(y1[0]), bf_hi(y1[0]), bf_lo(y1[1]), bf_hi(y1[1])};
                s0 += h0[c][0] * h0[c][0] + h0[c][1] * h0[c][1] + h0[c][2] * h0[c][2] + h0[c][3] * h0[c][3];
                s1 += h1[c][0] * h1[c][0] + h1[c][1] * h1[c][1] + h1[c][2] * h1[c][2] + h1[c][3] * h1[c][3];
            }
#pragma unroll
            for (int m = 32; m >= 1; m >>= 1) { s0 += __shfl_xor(s0, m); s1 += __shfl_xor(s1, m); }
            const float rs0 = rsqrtf(s0 * (1.f / 1024.f) + EPS), rs1 = rsqrtf(s1 * (1.f / 1024.f) + EPS);
#pragma unroll
            for (int c = 0; c < 4; ++c) { *(f32x4*)(op + c * 256 + lane * 4) = h0[c] * rs0 * g[c]; *(f32x4*)(op + 1024 + c * 256 + lane * 4) = h1[c] * rs1 * g[c]; }
        }
    }
}

__global__ void __launch_bounds__(NTHR, 2) hymba_fwd(Params p) {
    extern __shared__ __attribute__((aligned(16))) unsigned char lds_raw[];
    LAS unsigned char* lds = (LAS unsigned char*)lds_raw;
    const int lo = p.ph_lo, hi = p.ph_hi;
#define IN(k) (lo <= (k) && (k) < hi)
#if N_LAUNCHES == 1
    volatile LAS unsigned* bst = (volatile LAS unsigned*)(lds + 131072);
    if (threadIdx.x < 4) bst[threadIdx.x] = 0u;
    __syncthreads();
    const XcdBarrier bar = xcd_barrier_post((unsigned*)(p.ws + WS_BAR), bst);
#define SEAM(k) do { if (IN(k) && IN((k) + 1)) xcd_barrier(bar); } while (0)
#else
#define SEAM(k) do { } while (0)
#endif
#ifndef DUP_PHASE
#define DUP_PHASE -1
#endif
    if (IN(0)) phase0(lds, p, 0, 192 + 1280);
    SEAM(0);
    if (IN(1)) phase1(lds, p);
    SEAM(1);
    if (IN(2)) {
        pg8::Gemm g{(const bf16_t*)(p.ws + WS_A), (const bf16_t*)(p.ws + WS_WIN), NROWS, 4096, 1024};
        pg8::InOrder S; S.init(NLAT, 4096, gridDim.x, blockIdx.x);
        EpiIn E{p.ws, p.lb_logits};
#pragma unroll 1
        for (int rep = 0; rep < (DUP_PHASE == 2 ? 2 : 1); ++rep) pg8::gemm_phase<EpiIn, pg8::InOrder>(lds, g, S, E);
    }
    SEAM(2);
    if (IN(3)) {
#pragma unroll 1
        for (int rep = 0; rep < (DUP_PHASE == 3 ? 2 : 1); ++rep) scan_phase(lds, p);
    }
    SEAM(3);
    if (IN(4)) { conv_phase(lds, p); if (DUP_PHASE == 4) { __syncthreads(); conv_phase(lds, p); } }
    SEAM(4);
    if (IN(5)) {
        pg8::Gemm g{(const bf16_t*)(p.ws + WS_A), (const bf16_t*)(p.ws + WS_WOUT), NLAT, 1024, 1024};
        pg8::StaticOrder S; S.init(NLAT, 1024, gridDim.x, blockIdx.x);
        EpiOut E{(bf16_t*)(p.ws + WS_QF)};
#pragma unroll 1
        for (int rep = 0; rep < (DUP_PHASE == 5 ? 2 : 1); ++rep) pg8::gemm_phase<EpiOut, pg8::StaticOrder>(lds, g, S, E);
    }
    SEAM(5);
    if (IN(6)) final_phase(p);
}

extern "C" void kernel_launch(void* const* d_in, const int* in_sizes, int n_in, void* d_out, int out_size, void* d_ws, size_t ws_size, hipStream_t stream) {
    static int grid = 0;
    if (grid == 0) {
        int dev = 0, cus = 0, per_cu = 0;
        hipGetDevice(&dev);
        hipDeviceGetAttribute(&cus, hipDeviceAttributeMultiprocessorCount, dev);
        hipFuncSetAttribute((const void*)hymba_fwd, hipFuncAttributeMaxDynamicSharedMemorySize, LDS_BYTES);
        hipOccupancyMaxActiveBlocksPerMultiprocessor(&per_cu, (const void*)hymba_fwd, NTHR, LDS_BYTES);
        if (per_cu < 1) { fprintf(stderr, "kernel_launch: occupancy query says %d blocks/CU\n", per_cu); per_cu = 1; }
        grid = cus * per_cu;
        if (ws_size < WS_END) { fprintf(stderr, "kernel_launch: workspace too small (%zu < %zu)\n", ws_size, (size_t)WS_END); grid = -1; }
    }
    if (grid < 0) return;
    Params p{};
    p.x = (const float*)d_in[0]; p.c = (const float*)d_in[1]; p.ctx = (const float*)d_in[2]; p.c_ctx = (const float*)d_in[3]; p.norm_g = (const float*)d_in[4];
    p.w_mod = (const float*)d_in[5]; p.b_mod = (const float*)d_in[6]; p.w_in = (const float*)d_in[7]; p.lb_logits = (const float*)d_in[8]; p.hgrn_norm_g = (const float*)d_in[9];
    p.conv_w = (const float*)d_in[10]; p.conv_b = (const float*)d_in[11]; p.conv_ln_g = (const float*)d_in[12]; p.conv_ln_b = (const float*)d_in[13]; p.w_out = (const float*)d_in[14];
    p.final_norm_g = (const float*)d_in[15];
    p.out = (float*)d_out; p.ws = (unsigned char*)d_ws;
#if N_LAUNCHES == 1
    p.ph_lo = 0; p.ph_hi = 7;
    hipMemsetAsync((unsigned char*)d_ws + WS_BAR, 0, XCD_BAR_WORDS * 4, stream);
    void* args[] = {&p};
    hipError_t e = hipLaunchCooperativeKernel((const void*)hymba_fwd, dim3(grid), dim3(NTHR), args, LDS_BYTES, stream);
    if (e != hipSuccess) fprintf(stderr, "cooperative launch failed: %s (grid %d)\n", hipGetErrorString(e), grid);
#else
    for (int ph = 0; ph < 7; ++ph) { p.ph_lo = ph; p.ph_hi = ph + 1; hipLaunchKernelGGL(hymba_fwd, dim3(grid), dim3(NTHR), LDS_BYTES, stream, p); }
#endif
}
```
